# Optimizing an MI355X kernel written in HIP

```python
import math
import jax, jax.numpy as jnp
from jax import lax
import numpy as np

D_MODEL = 1024
BATCH = 4
SEQ = 4096
DEPTH = 2
DEC_BATCH = 16
DEC_SEQ = 16
PAST_LEN = 1024

CHUNK = 64
EPS = 1e-6
NEG_INF = -1e30
N_HEADS = 8
N_KV_HEADS = 2
HEAD_DIM = 64
Q_PER_KV = N_HEADS // N_KV_HEADS
ATT_WIDTH = N_HEADS * HEAD_DIM
KV_WIDTH = N_KV_HEADS * HEAD_DIM
WINDOW = 128
WIN_CHUNKS = WINDOW // CHUNK
NUM_BUCKETS = 32
MAX_DISTANCE = 128
SSD_INNER = D_MODEL
SSD_HEAD_DIM = 64
SSD_HEADS = SSD_INNER // SSD_HEAD_DIM
SSD_GROUPS = 2
SSD_HPG = SSD_HEADS // SSD_GROUPS
SSD_STATE = 128
CONV_W = 4
CONV_DIM = SSD_INNER + 2 * SSD_GROUPS * SSD_STATE
SSD_BLOCK = CHUNK
DT_MIN = 1e-3
DT_MAX = 1e-1
D_FF = -(-8 * D_MODEL // (3 * 256)) * 256
IN_SPLITS = (ATT_WIDTH, KV_WIDTH, KV_WIDTH, SSD_INNER, CONV_DIM, SSD_HEADS, D_MODEL, D_MODEL)
IN_WIDTH = sum(IN_SPLITS)

kernel_name = 'hybrid_swa_sink_ssd_stream_encoder_step'


def rmsnorm(x, g):
    xf = x.astype(jnp.float32)
    y = xf * lax.rsqrt(jnp.mean(xf * xf, axis=-1, keepdims=True) + EPS)
    return (y * g.astype(jnp.float32)).astype(x.dtype)


def t5_bucket(rel):
    nb = NUM_BUCKETS // 2
    max_exact = nb // 2
    ret = jnp.where(rel > 0, nb, 0)
    n = jnp.abs(rel)
    nf = jnp.maximum(n, 1).astype(jnp.float32)
    large = max_exact + (jnp.log(nf / max_exact) / math.log(MAX_DISTANCE / max_exact)
                         * (nb - max_exact)).astype(jnp.int32)
    large = jnp.minimum(large, nb - 1)
    return ret + jnp.where(n < max_exact, n, large)


def rel_bias(rel, table):
    b = table[t5_bucket(rel)].astype(jnp.float32)
    return jnp.moveaxis(b, -1, 0).reshape(N_KV_HEADS, Q_PER_KV, rel.shape[0], rel.shape[1])


def sink_attention(q, k, v, bias, sinks, kmask):
    logits = jnp.einsum('bxqgrd,bxkgd->bxgrqk', q.astype(jnp.float32), k.astype(jnp.float32))
    logits = logits * (HEAD_DIM ** -0.5) + bias
    if kmask is not None:
        logits = jnp.where(kmask[:, :, None, None, None, :], logits, NEG_INF)
    s = sinks.astype(jnp.float32).reshape(1, 1, N_KV_HEADS, Q_PER_KV, 1, 1)
    m = jnp.maximum(jnp.max(logits, axis=-1, keepdims=True), s)
    p = jnp.exp(logits - m)
    denom = jnp.sum(p, axis=-1, keepdims=True) + jnp.exp(s - m)
    return jnp.einsum('bxgrqk,bxkgd->bxqgrd', p / denom, v.astype(jnp.float32))


def attn_prompt(q, k, v, table, sinks, kv_len):
    b, s = q.shape[0], q.shape[1]
    nc = s // CHUNK
    pad = WIN_CHUNKS * CHUNK
    lk = pad + CHUNK
    qb = q.reshape(b, nc, CHUNK, N_KV_HEADS, Q_PER_KV, HEAD_DIM)

    def band(t):
        tp = jnp.pad(t, ((0, 0), (pad, 0), (0, 0), (0, 0)))
        tp = tp.reshape(b, nc + WIN_CHUNKS, CHUNK, N_KV_HEADS, HEAD_DIM)
        return jnp.concatenate([tp[:, i:i + nc] for i in range(WIN_CHUNKS + 1)], axis=2)

    qi = jnp.arange(CHUNK, dtype=jnp.int32)
    kj = jnp.arange(lk, dtype=jnp.int32)
    bias = rel_bias(kj[None, :] - pad - qi[:, None], table)
    kpos = (jnp.arange(nc, dtype=jnp.int32)[:, None] - WIN_CHUNKS) * CHUNK + kj[None, :]
    o = sink_attention(qb, band(k), band(v), bias, sinks, (kpos >= 0)[None])
    return o.reshape(b, s, ATT_WIDTH), k[:, s - kv_len:], v[:, s - kv_len:]


def attn_sample(q, k, v, k_cache, v_cache, table, sinks):
    b, t = q.shape[0], q.shape[1]
    kv_len = k_cache.shape[1]
    kk = jnp.concatenate([k_cache.astype(k.dtype), k], axis=1)
    vv = jnp.concatenate([v_cache.astype(v.dtype), v], axis=1)
    qpos = PAST_LEN + jnp.arange(t, dtype=jnp.int32)
    kpos = PAST_LEN - kv_len + jnp.arange(kv_len + t, dtype=jnp.int32)
    bias = rel_bias(kpos[None, :] - qpos[:, None], table)
    o = sink_attention(q.reshape(b, 1, t, N_KV_HEADS, Q_PER_KV, HEAD_DIM),
                       kk[:, None], vv[:, None], bias, sinks, None)
    return o.reshape(b, t, ATT_WIDTH), kk[:, t:], vv[:, t:]


def causal_conv(xbc, hist, w, bias):
    xp = jnp.concatenate([hist.astype(xbc.dtype), xbc], axis=1)
    out = lax.conv_general_dilated(xp, w[:, None, :].astype(xp.dtype), window_strides=(1,),
                                   padding='VALID', dimension_numbers=('NWC', 'WIO', 'NWC'),
                                   feature_group_count=CONV_DIM)
    return jax.nn.silu(out + bias.astype(xp.dtype)), xp[:, -(CONV_W - 1):]


def ssd_scan(x, dt, a, bm, cm, h0, block):
    b, s = x.shape[0], x.shape[1]
    nc = s // block
    f32 = jnp.float32
    xr = x.astype(f32).reshape(b, nc, block, SSD_GROUPS, SSD_HPG, SSD_HEAD_DIM)
    dtr = dt.reshape(b, nc, block, SSD_GROUPS, SSD_HPG)
    br = bm.astype(f32).reshape(b, nc, block, SSD_GROUPS, SSD_STATE)
    cr = cm.astype(f32).reshape(b, nc, block, SSD_GROUPS, SSD_STATE)
    acum = jnp.cumsum(dtr * a.reshape(SSD_GROUPS, SSD_HPG), axis=2)
    ac = jnp.moveaxis(acum, 2, -1)
    causal = jnp.tril(jnp.ones((block, block), dtype=bool))
    lmat = jnp.exp(jnp.where(causal, ac[..., :, None] - ac[..., None, :], -jnp.inf))
    cb = jnp.einsum('bclgn,bcsgn->bcgls', cr, br)
    y_diag = jnp.einsum('bcgls,bcghls,bcsgh,bcsghp->bclghp', cb, lmat, dtr, xr)
    decay_end = jnp.exp(ac[..., -1:] - ac)
    st = jnp.einsum('bclgn,bcghl,bclgh,bclghp->bcghpn', br, decay_end, dtr, xr)
    blk_decay = jnp.exp(ac[..., -1])

    def step(h, inp):
        s_c, d_c = inp
        return d_c[..., None, None] * h + s_c, h

    h_init = h0.astype(f32).reshape(b, SSD_GROUPS, SSD_HPG, SSD_HEAD_DIM, SSD_STATE)
    h_fin, h_prev = lax.scan(step, h_init, (jnp.moveaxis(st, 1, 0), jnp.moveaxis(blk_decay, 1, 0)))
    h_prev = jnp.moveaxis(h_prev, 0, 1)
    y_off = jnp.einsum('bclgn,bcghpn,bcghl->bclghp', cr, h_prev, jnp.exp(ac))
    y = (y_diag + y_off).reshape(b, s, SSD_HEADS, SSD_HEAD_DIM)
    return y, h_fin.reshape(b, SSD_HEADS, SSD_HEAD_DIM, SSD_STATE)


def trunk_layer(x, attn_fn, conv_hist, ssm0, ssd_block, g_mix, w_in, conv_w, conv_b, dt_bias, a_log,
                d_skip, g_ssd, w_att_out, w_ssd_out, w_out, g_ffn, w_gate, w_up, w_down):
    b, t = x.shape[0], x.shape[1]
    f32 = jnp.float32
    hn = rmsnorm(x, g_mix)
    u = hn @ w_in
    q, k, v, z, xbc, dt_raw, gate_a, gate_s = jnp.split(u, np.cumsum(IN_SPLITS)[:-1].tolist(), axis=-1)
    o_att, k_state, v_state = attn_fn(q, k.reshape(b, t, N_KV_HEADS, HEAD_DIM),
                                      v.reshape(b, t, N_KV_HEADS, HEAD_DIM))
    xbc, conv_state = causal_conv(xbc, conv_hist, conv_w, conv_b)
    xs, bm, cm = jnp.split(xbc, [SSD_INNER, SSD_INNER + SSD_GROUPS * SSD_STATE], axis=-1)
    dt = jax.nn.softplus(dt_raw.astype(f32) + dt_bias.astype(f32))
    a = -jnp.exp(a_log.astype(f32))
    xh = xs.reshape(b, t, SSD_HEADS, SSD_HEAD_DIM)
    y, ssm_state = ssd_scan(xh, dt, a, bm.reshape(b, t, SSD_GROUPS, SSD_STATE),
                            cm.reshape(b, t, SSD_GROUPS, SSD_STATE), ssm0, ssd_block)
    y = y + xh.astype(f32) * d_skip.astype(f32)[:, None]
    y = y.reshape(b, t, SSD_INNER) * jax.nn.silu(z.astype(f32))
    y_ssd = rmsnorm(y, g_ssd).astype(x.dtype)
    merged = (jax.nn.sigmoid(gate_a) * (o_att.astype(x.dtype) @ w_att_out)
              + jax.nn.sigmoid(gate_s) * (y_ssd @ w_ssd_out))
    h = x + merged @ w_out
    hf = rmsnorm(h, g_ffn)
    out = h + (jax.nn.silu(hf @ w_gate) * (hf @ w_up)) @ w_down
    return out, (k_state, v_state, conv_state, ssm_state.astype(x.dtype))


def setup_inputs(seed: int = 0) -> dict:
    key = jax.random.key(seed)
    k = jax.random.split(key, 24)
    f32 = jnp.float32
    kv_len = min(WINDOW, PAST_LEN)

    def nrm(kk, shape, scale):
        return jax.random.normal(kk, shape, f32) * scale

    dt0 = jnp.exp(jax.random.uniform(k[10], (DEPTH, SSD_HEADS), f32, math.log(DT_MIN), math.log(DT_MAX)))
    return {
        'x_prompt': nrm(k[0], (BATCH, SEQ, D_MODEL), 1.0),
        'x_sample': nrm(k[1], (DEC_BATCH, DEC_SEQ, D_MODEL), 1.0),
        'cache_k': nrm(k[2], (DEPTH, DEC_BATCH, kv_len, N_KV_HEADS, HEAD_DIM), 1.0),
        'cache_v': nrm(k[3], (DEPTH, DEC_BATCH, kv_len, N_KV_HEADS, HEAD_DIM), 1.0),
        'state_conv': nrm(k[4], (DEPTH, DEC_BATCH, CONV_W - 1, CONV_DIM), 1.0),
        'state_ssm': nrm(k[5], (DEPTH, DEC_BATCH, SSD_HEADS, SSD_HEAD_DIM, SSD_STATE), 0.1),
        'rel_table': nrm(k[6], (NUM_BUCKETS, N_HEADS), 0.5),
        'g_mix': 1.0 + nrm(k[7], (DEPTH, D_MODEL), 0.02),
        'w_in': nrm(k[8], (DEPTH, D_MODEL, IN_WIDTH), D_MODEL ** -0.5),
        'conv_w': nrm(k[9], (DEPTH, CONV_W, CONV_DIM), CONV_W ** -0.5),
        'conv_b': nrm(k[11], (DEPTH, CONV_DIM), 0.02),
        'dt_bias': dt0 + jnp.log(-jnp.expm1(-dt0)),
        'a_log': jnp.log(jax.random.uniform(k[12], (DEPTH, SSD_HEADS), f32, 1.0, 16.0)),
        'd_skip': 1.0 + nrm(k[13], (DEPTH, SSD_HEADS), 0.1),
        'g_ssd': 1.0 + nrm(k[14], (DEPTH, SSD_INNER), 0.02),
        'sinks': nrm(k[15], (DEPTH, N_HEADS), 0.5),
        'w_att_out': nrm(k[16], (DEPTH, ATT_WIDTH, D_MODEL), ATT_WIDTH ** -0.5),
        'w_ssd_out': nrm(k[17], (DEPTH, SSD_INNER, D_MODEL), SSD_INNER ** -0.5),
        'w_out': nrm(k[18], (DEPTH, D_MODEL, D_MODEL), D_MODEL ** -0.5),
        'g_ffn': 1.0 + nrm(k[19], (DEPTH, D_MODEL), 0.02),
        'w_gate': nrm(k[20], (DEPTH, D_MODEL, D_FF), D_MODEL ** -0.5),
        'w_up': nrm(k[21], (DEPTH, D_MODEL, D_FF), D_MODEL ** -0.5),
        'w_down': nrm(k[22], (DEPTH, D_FF, D_MODEL), D_FF ** -0.5),
        'g_final': 1.0 + nrm(k[23], (D_MODEL,), 0.02),
    }


def reference(x_prompt, x_sample, cache_k, cache_v, state_conv, state_ssm, rel_table, g_mix, w_in,
              conv_w, conv_b, dt_bias, a_log, d_skip, g_ssd, sinks, w_att_out, w_ssd_out, w_out,
              g_ffn, w_gate, w_up, w_down, g_final):
    kv_len = cache_k.shape[2]
    xp, xs = x_prompt, x_sample
    bp = xp.shape[0]
    st_p, st_s = [], []
    for l in range(DEPTH):
        lw = (g_mix[l], w_in[l], conv_w[l], conv_b[l], dt_bias[l], a_log[l], d_skip[l], g_ssd[l],
              w_att_out[l], w_ssd_out[l], w_out[l], g_ffn[l], w_gate[l], w_up[l], w_down[l])
        sl = sinks[l]
        xp, sp = trunk_layer(
            xp, lambda q, k, v, sl=sl: attn_prompt(q, k, v, rel_table, sl, kv_len),
            jnp.zeros((bp, CONV_W - 1, CONV_DIM), xp.dtype),
            jnp.zeros((bp, SSD_HEADS, SSD_HEAD_DIM, SSD_STATE), jnp.float32),
            SSD_BLOCK, *lw)
        xs, ss = trunk_layer(
            xs, lambda q, k, v, sl=sl, kc=cache_k[l], vc=cache_v[l]: attn_sample(q, k, v, kc, vc, rel_table, sl),
            state_conv[l], state_ssm[l], xs.shape[1], *lw)
        st_p.append(sp)
        st_s.append(ss)
    y_prompt = rmsnorm(xp, g_final)
    y_sample = rmsnorm(xs, g_final)
    k_prompt = jnp.stack([s[0] for s in st_p])
    v_prompt = jnp.stack([s[1] for s in st_p])
    conv_prompt = jnp.stack([s[2] for s in st_p])
    ssm_prompt = jnp.stack([s[3] for s in st_p])
    k_sample = jnp.stack([s[0] for s in st_s])
    v_sample = jnp.stack([s[1] for s in st_s])
    conv_sample = jnp.stack([s[2] for s in st_s])
    ssm_sample = jnp.stack([s[3] for s in st_s])
    return (y_prompt, y_sample, k_prompt, v_prompt, conv_prompt, ssm_prompt,
            k_sample, v_sample, conv_sample, ssm_sample)
```

```cpp
#include <hip/hip_runtime.h>
#include <cstdio>
#include <cstdint>
namespace pg8 {
#define PG8_LAS __attribute__((address_space(3)))
typedef unsigned short bf16_t;
typedef short bf16x8 __attribute__((ext_vector_type(8)));
typedef float f32x4 __attribute__((ext_vector_type(4)));
typedef unsigned u32x4 __attribute__((ext_vector_type(4)));
constexpr int BM = 256, BK = 64, HALF = 128, HTB = HALF * BK * 2  , STAGE_BYTES = 8 * HTB, NXCD = 8, WGM = 8;

__host__ __device__ __forceinline__ int lds_byte(int r, int c) { const int st = (r >> 4) * 2 + (c >> 5), rr = r & 15, cc = c & 31, ob = rr * 64 + cc * 2; return st * 1024 + (ob ^ (((ob >> 9) & 1) << 5)); }
__host__ __device__ __forceinline__ void stage_rc(int b, int& R, int& C) { const int st = b / 1024, sb = b % 1024, swz = sb ^ (((sb >> 9) & 1) << 5); R = (st >> 1) * 16 + swz / 64; C = (st & 1) * 32 + (swz % 64) / 2; }
__host__ __device__ __forceinline__ int perm32(int rho) { const int n = rho >> 4, i = rho & 15; return 8 * (i >> 2) + 4 * n + (i & 3); }

struct Unit { int pm, pn; };
struct Gemm { const bf16_t* A; const bf16_t* Bt; int M, N, K; };

struct StaticOrder {
    int nM, nN, nwg, G, c;
    __host__ __device__ void init(int M, int N, int G_, int c_) { nM = M / BM; nN = N / BM; nwg = nM * nN; G = G_; c = c_; }
    __host__ __device__ bool next(int i, Unit& u) const {
        const long L = (long)i * G + c; if (L >= nwg) return false;
        int wgid = (int)L; { const int q = nwg / NXCD, r = nwg % NXCD, xcd = wgid % NXCD, off = wgid / NXCD; wgid = (xcd < r ? xcd * (q + 1) : r * (q + 1) + (xcd - r) * q) + off; }
        const int nig = WGM * nN, gid = wgid / nig, fm = gid * WGM, gsz = (nM - fm) < WGM ? (nM - fm) : WGM;
        u.pm = fm + ((wgid % nig) % gsz); u.pn = (wgid % nig) / gsz; return true;
    }
    __device__ __forceinline__ void a_ready(const Unit&) const {}
    __device__ __forceinline__ void done(const Unit&) const {}
};

__device__ __forceinline__ unsigned cvt_pk_bf16(float lo, float hi) { unsigned r; asm volatile("v_cvt_pk_bf16_f32 %0, %1, %2" : "=v"(r) : "v"(lo), "v"(hi)); return r; }
typedef float f32x2 __attribute__((ext_vector_type(2)));
template <class Epi, class Sched, bool ALIGN_EPI = false, bool SP2 = false>
__device__ __forceinline__ void gemm_phase(PG8_LAS unsigned char* lds, const Gemm g, const Sched& S, const Epi& E) {
    int tid_ = threadIdx.x; asm volatile("" : "+v"(tid_));
    const int tid = tid_, wid = __builtin_amdgcn_readfirstlane(tid >> 6), lane = tid & 63, wr = wid >> 2, wc = wid & 3, fr = lane & 15, fq = lane >> 4;
    const int K = g.K, nt = K / BK;
    unsigned voffA[2], voffB[2];
#pragma unroll
    for (int i = 0; i < 2; ++i) { int R, C; stage_rc(tid * 16 + i * 8192, R, C); const int Rb = Epi::PERM ? ((R & ~31) + perm32(R & 31)) : R;
        voffA[i] = (unsigned)(R * K + C) * 2u; voffB[i] = (unsigned)(Rb * K + C) * 2u; }
    const size_t kstep = (size_t)(BK * 2);
    const size_t hstep = (size_t)HALF * K * 2;
    const size_t tstep = 2 * hstep;
    const unsigned ldsw = (unsigned)wid * 1024u;
    const int aoff = lds_byte(wr * 64 + fr, fq * 8), boff = lds_byte(wc * 32 + fr, fq * 8);
#define PG8_SA(b, h) (((b) * 2 + (h)) * HTB)
#define PG8_SB(b, h) ((4 + (b) * 2 + (h)) * HTB)
#define PG8_STAGE(bufoff, gbase, voff) do { _Pragma("unroll") for (int _i = 0; _i < 2; ++_i) \
        __builtin_amdgcn_global_load_lds((const unsigned*)((const char*)(gbase) + (voff)[_i]), (PG8_LAS unsigned*)(lds + (bufoff) + ldsw + _i * 8192), 16, 0, 0); } while (0)
#define PG8_LDA(dst, b, h) do { _Pragma("unroll") for (int m = 0; m < 4; ++m) _Pragma("unroll") for (int k = 0; k < 2; ++k) dst[m][k] = *(const PG8_LAS bf16x8*)(lds + PG8_SA(b, h) + aoff + m * 2048 + k * 1024); } while (0)
#define PG8_LDB(dst, b, h) do { _Pragma("unroll") for (int n = 0; n < 2; ++n) _Pragma("unroll") for (int k = 0; k < 2; ++k) dst[n][k] = *(const PG8_LAS bf16x8*)(lds + PG8_SB(b, h) + boff + n * 2048 + k * 1024); } while (0)
#define PG8_MMA(ai, bj, At, Bt) do { __builtin_amdgcn_s_setprio(1); _Pragma("unroll") for (int m = 0; m < 4; ++m) _Pragma("unroll") for (int n = 0; n < 2; ++n) _Pragma("unroll") for (int k = 0; k < 2; ++k) \
        acc[ai][bj][m][n] = __builtin_amdgcn_mfma_f32_16x16x32_bf16(Bt[n][k], At[m][k], acc[ai][bj][m][n], 0, 0, 0); __builtin_amdgcn_s_setprio(0); } while (0)
#define PG8_WAIT_V(n) asm volatile("s_waitcnt vmcnt(" #n ")" ::: "memory")
#define PG8_WAIT_L(n) asm volatile("s_waitcnt lgkmcnt(" #n ")" ::: "memory")
#define PG8_BAR __builtin_amdgcn_s_barrier()
#define PG8_SCHED __builtin_amdgcn_sched_barrier(0)
    Unit cur, nxt; int ui = 0;
    if (!S.next(0, cur)) return;
    f32x4 acc[2][2][4][2];
#pragma unroll
    for (int a = 0; a < 2; ++a)
#pragma unroll
        for (int b = 0; b < 2; ++b)
#pragma unroll
            for (int m = 0; m < 4; ++m)
#pragma unroll
                for (int n = 0; n < 2; ++n) acc[a][b][m][n] = (f32x4){0.f, 0.f, 0.f, 0.f};
    bf16x8 At[4][2], B0[2][2], B1[2][2];
    const char* cA = (const char*)g.A + (size_t)cur.pm * tstep; const char* cB = (const char*)g.Bt + (size_t)cur.pn * tstep;
    S.a_ready(cur);
    if constexpr (SP2) {
        PG8_STAGE(PG8_SB(0, 0), cB, voffB); PG8_STAGE(PG8_SB(0, 1), cB + hstep, voffB); PG8_STAGE(PG8_SA(0, 0), cA, voffA); PG8_STAGE(PG8_SA(0, 1), cA + hstep, voffA);
        if (wr == 1) PG8_BAR;
        PG8_WAIT_V(2); PG8_BAR;
        PG8_STAGE(PG8_SB(1, 0), cB + kstep, voffB); PG8_STAGE(PG8_SA(1, 0), cA + kstep, voffA); PG8_STAGE(PG8_SB(1, 1), cB + hstep + kstep, voffB);
        PG8_WAIT_V(6); PG8_BAR;
    } else {
        PG8_STAGE(PG8_SB(0, 0), cB, voffB); PG8_STAGE(PG8_SA(0, 0), cA, voffA); PG8_STAGE(PG8_SB(0, 1), cB + hstep, voffB); PG8_STAGE(PG8_SA(0, 1), cA + hstep, voffA);
        if (wr == 1) PG8_BAR;
        PG8_WAIT_V(4); PG8_BAR;
        PG8_STAGE(PG8_SB(1, 0), cB + kstep, voffB); PG8_STAGE(PG8_SA(1, 0), cA + kstep, voffA); PG8_STAGE(PG8_SB(1, 1), cB + hstep + kstep, voffB);
        PG8_WAIT_V(6); PG8_BAR;
    }
    for (;;) {
        const bool has_next = S.next(ui + 1, nxt);
        const char* nA = has_next ? (const char*)g.A + (size_t)nxt.pm * tstep : cA; const char* nB = has_next ? (const char*)g.Bt + (size_t)nxt.pn * tstep : cB;
        for (int t = 0; t < nt; t += 2) {
            const bool last = (t == nt - 2);
            const char* a1 = cA + (size_t)(t + 1) * kstep;
            const char* a2 = last ? nA : cA + (size_t)(t + 2) * kstep; const char* b2 = last ? nB : cB + (size_t)(t + 2) * kstep;
            const char* a3 = a2 + kstep; const char* b3 = b2 + kstep;
            if (last && has_next) S.a_ready(nxt);
            if constexpr (SP2) {
            PG8_LDB(B0, 0, 0); PG8_LDB(B1, 0, 1); PG8_SCHED; PG8_LDA(At, 0, 0); PG8_STAGE(PG8_SA(1, 1), a1 + hstep, voffA);
            PG8_WAIT_V(8); PG8_WAIT_L(0); PG8_BAR; PG8_MMA(0, 0, At, B0); PG8_MMA(0, 1, At, B1); PG8_BAR; PG8_SCHED;
            PG8_LDA(At, 0, 1); PG8_STAGE(PG8_SB(0, 0), b2, voffB); PG8_STAGE(PG8_SB(0, 1), b2 + hstep, voffB); PG8_STAGE(PG8_SA(0, 0), a2, voffA);
            PG8_WAIT_V(8); PG8_WAIT_L(0); PG8_BAR; PG8_MMA(1, 0, At, B0); PG8_MMA(1, 1, At, B1); PG8_BAR; PG8_SCHED;
            PG8_LDB(B0, 1, 0); PG8_LDB(B1, 1, 1); PG8_SCHED; PG8_LDA(At, 1, 0); PG8_STAGE(PG8_SA(0, 1), a2 + hstep, voffA);
            PG8_WAIT_V(8); PG8_WAIT_L(0); PG8_BAR; PG8_MMA(0, 0, At, B0); PG8_MMA(0, 1, At, B1); PG8_BAR; PG8_SCHED;
            PG8_LDA(At, 1, 1); PG8_STAGE(PG8_SB(1, 0), b3, voffB); PG8_STAGE(PG8_SB(1, 1), b3 + hstep, voffB); PG8_STAGE(PG8_SA(1, 0), a3, voffA);
            PG8_WAIT_V(8); PG8_WAIT_L(0); PG8_BAR; PG8_MMA(1, 0, At, B0); PG8_MMA(1, 1, At, B1); PG8_BAR; PG8_SCHED;
            } else {
            PG8_LDB(B0, 0, 0); PG8_SCHED; PG8_LDA(At, 0, 0); PG8_STAGE(PG8_SA(1, 1), a1 + hstep, voffA);
            PG8_WAIT_L(8); PG8_BAR; PG8_WAIT_L(0); PG8_MMA(0, 0, At, B0); PG8_BAR; PG8_SCHED;
            PG8_LDB(B1, 0, 1); PG8_STAGE(PG8_SB(0, 0), b2, voffB);
            PG8_BAR; PG8_WAIT_L(0); PG8_MMA(0, 1, At, B1); PG8_BAR;
            PG8_LDA(At, 0, 1); PG8_STAGE(PG8_SA(0, 0), a2, voffA);
            PG8_BAR; PG8_WAIT_L(0); PG8_MMA(1, 0, At, B0); PG8_BAR; PG8_SCHED;
            PG8_STAGE(PG8_SB(0, 1), b2 + hstep, voffB);
            PG8_WAIT_V(6); PG8_BAR; PG8_MMA(1, 1, At, B1); PG8_BAR;
            PG8_LDB(B0, 1, 0); PG8_SCHED; PG8_LDA(At, 1, 0); PG8_STAGE(PG8_SA(0, 1), a2 + hstep, voffA);
            PG8_WAIT_L(8); PG8_BAR; PG8_WAIT_L(0); PG8_MMA(0, 0, At, B0); PG8_BAR; PG8_SCHED;
            PG8_LDB(B1, 1, 1); PG8_STAGE(PG8_SB(1, 0), b3, voffB);
            PG8_BAR; PG8_WAIT_L(0); PG8_MMA(0, 1, At, B1); PG8_BAR;
            PG8_LDA(At, 1, 1); PG8_STAGE(PG8_SA(1, 0), a3, voffA);
            PG8_BAR; PG8_WAIT_L(0); PG8_MMA(1, 0, At, B0); PG8_BAR; PG8_SCHED;
            PG8_STAGE(PG8_SB(1, 1), b3 + hstep, voffB);
            PG8_WAIT_V(6); PG8_BAR; PG8_MMA(1, 1, At, B1); PG8_BAR;
            }
        }
        if constexpr (ALIGN_EPI) { if (wr == 0) PG8_BAR; }
        if constexpr (!Epi::AFTER_DRAIN) { E(acc, cur, wr, wc, fr, fq); S.done(cur); }
        if (!has_next) break;
#pragma unroll
        for (int a = 0; a < 2; ++a)
#pragma unroll
            for (int b = 0; b < 2; ++b)
#pragma unroll
                for (int m = 0; m < 4; ++m)
#pragma unroll
                    for (int n = 0; n < 2; ++n) acc[a][b][m][n] = (f32x4){0.f, 0.f, 0.f, 0.f};
        cur = nxt; cA = nA; cB = nB; ++ui;
        if constexpr (ALIGN_EPI) { if (wr == 1) PG8_BAR; }
    }
    PG8_WAIT_V(0);
    if constexpr (!ALIGN_EPI) { if (wr == 0) PG8_BAR; }
    PG8_BAR;
    if constexpr (Epi::AFTER_DRAIN) { E.fused(acc, cur, wr, wc, fr, fq, lds, wid, lane); S.done(cur); }
#undef PG8_SA
#undef PG8_SB
#undef PG8_STAGE
#undef PG8_LDA
#undef PG8_LDB
#undef PG8_MMA
#undef PG8_WAIT_V
#undef PG8_WAIT_L
#undef PG8_BAR
#undef PG8_SCHED
}
}

#ifndef MK_SPLIT
#define MK_SPLIT 1
#endif
#ifndef PH_MASK
#define PH_MASK 0xff
#endif
#define PH_EN(k) (((PH_MASK) >> (k)) & 1)
#ifndef MIX_MASK
#define MIX_MASK 0xf
#endif
#define MIX_EN(k) (((MIX_MASK) >> (k)) & 1)
constexpr int NWAVES = 8;
constexpr int MP = 16384, MS = 256, MALL = MP + MS, DM = 1024, NU = 5632, DFF = 2816;
constexpr int NPHASE = 15;
constexpr size_t KiB = 1024, MiB = 1u << 20;
constexpr size_t WS_CTL = 0, CTL_ZERO_BYTES = 1 * MiB;
constexpr size_t WS_SSQX = 1 * MiB, WS_SSQY = WS_SSQX + 1280 * KiB, WS_SSQH = WS_SSQY + 1280 * KiB, WS_DT = WS_SSQH + 1280 * KiB;
constexpr size_t WS_WIN = 6 * MiB, WS_WGU = WS_WIN + 11 * MiB, WS_WATT = WS_WGU + 11 * MiB, WS_WSSD = WS_WATT + 1 * MiB, WS_WOUT = WS_WSSD + 2 * MiB, WS_WDN = WS_WOUT + 2 * MiB;
constexpr size_t WS_XB = WS_WDN + 5632 * KiB;
constexpr size_t WS_Q = WS_XB + (size_t)MALL * 1024 * 2;
constexpr size_t WS_KV = WS_Q + (size_t)MALL * 512 * 2;
constexpr size_t WS_Z = WS_KV + (size_t)MALL * 256 * 2;
constexpr size_t WS_XBC = WS_Z + (size_t)MALL * 1024 * 2;
constexpr size_t WS_GA = WS_XBC + (size_t)MALL * 1536 * 2;
constexpr size_t WS_GS = WS_GA + (size_t)MALL * 1024 * 2;
constexpr size_t WS_END = WS_GS + (size_t)MALL * 1024 * 2;
constexpr size_t WS_MG = WS_XBC;
constexpr size_t WS_ACT = WS_Q;
static_assert(WS_END <= 256 * MiB, "d_ws map");
static_assert(WS_ACT + (size_t)MALL * DFF * 2 <= WS_GA, "ACT overlay");
static_assert(WS_XB % 256 == 0 && WS_Q % 256 == 0 && WS_KV % 256 == 0 && WS_Z % 256 == 0 && WS_XBC % 256 == 0 && WS_GA % 256 == 0, "align");
constexpr int CW_BAR = 4096;
constexpr size_t O_Y = 0, O_KP = 17039360, O_VP = 17170432, O_CP = 17301504, O_SP = 17338368, O_KS = 18386944, O_VS = 18911232, O_CS = 19435520, O_SS = 19582976, O_END = 23777280;
constexpr int RING_BYTES = 131072, LDSCTL_OFF = RING_BYTES, MISC_OFF = LDSCTL_OFF + 320, LDS_BYTES = 147456;


namespace epi {
using pg8::bf16_t; using pg8::f32x4; using pg8::u32x4; using pg8::Unit; using pg8::cvt_pk_bf16;
__device__ __forceinline__ float bflo(unsigned w) { return __uint_as_float(w << 16); }
__device__ __forceinline__ float bfhi(unsigned w) { return __uint_as_float(w & 0xffff0000u); }
__device__ __forceinline__ float sigm(float x) { return __builtin_amdgcn_rcpf(1.0f + __expf(-x)); }
__device__ __forceinline__ float row_rs(const float* ssq, int row) {
    const f32x4* p = (const f32x4*)(ssq + (size_t)row * 16);
    const f32x4 a = p[0], b = p[1], c = p[2], d = p[3];
    const float s = (((a[0] + a[1]) + (a[2] + a[3])) + ((b[0] + b[1]) + (b[2] + b[3]))) + (((c[0] + c[1]) + (c[2] + c[3])) + ((d[0] + d[1]) + (d[2] + d[3])));
    return rsqrtf(s * (1.0f / 1024.0f) + 1e-6f);
}
__device__ __forceinline__ u32x4 pack8(const f32x4 v0, const f32x4 v1) {
    u32x4 w; w.x = cvt_pk_bf16(v0[0], v0[1]); w.y = cvt_pk_bf16(v0[2], v0[3]); w.z = cvt_pk_bf16(v1[0], v1[1]); w.w = cvt_pk_bf16(v1[2], v1[3]); return w;
}
__device__ __forceinline__ void unpack8(const u32x4 w, f32x4& v0, f32x4& v1) {
    v0 = (f32x4){bflo(w.x), bfhi(w.x), bflo(w.y), bfhi(w.y)}; v1 = (f32x4){bflo(w.z), bfhi(w.z), bflo(w.w), bfhi(w.w)};
}
__device__ __forceinline__ float softplus(float x) { return fmaxf(x, 0.f) + log1pf(__expf(-fabsf(x))); }

struct EpiIn {
    static constexpr bool PERM = true, AFTER_DRAIN = false;
    unsigned char* ws; const float* dt_bias;
    __device__ __forceinline__ void operator()(const f32x4 (&acc)[2][2][4][2], const Unit& u, int wr, int wc, int fr_, int fq_) const {
        int fr = fr_, fq = fq_; asm volatile("" : "+v"(fr), "+v"(fq));
        const int pn = u.pn, row0 = u.pm * 256 + wr * 64 + fr, cl = wc * 32 + 8 * fq;
        const float* ssq = (const float*)(ws + WS_SSQX); float* DT = (float*)(ws + WS_DT);
        size_t boff = WS_Q; int ldc = 512, colt = 0, mode = 0;
        if (pn < 2) { boff = WS_Q; ldc = 512; colt = pn * 256; }
        else if (pn == 2) { boff = WS_KV; ldc = 256; colt = 0; }
        else if (pn < 7) { boff = WS_Z; ldc = 1024; colt = (pn - 3) * 256; }
        else if (pn < 13) { boff = WS_XBC; ldc = 1536; colt = (pn - 7) * 256; }
        else if (pn < 17) { boff = WS_GA; ldc = 1024; colt = (pn - 13) * 256; mode = 1; }
        else if (pn < 21) { boff = WS_GS; ldc = 1024; colt = (pn - 17) * 256; mode = 1; }
        else mode = 2;
        bf16_t* base = (bf16_t*)(ws + boff);
#pragma unroll
        for (int ai = 0; ai < 2; ++ai)
#pragma unroll
            for (int m = 0; m < 4; ++m) {
                const int row = row0 + ai * 128 + m * 16; const float rs = row_rs(ssq, row);
                if (mode == 2) {
                    if (wc == 0 && fq < 2) {
                        const f32x4 b0 = *(const f32x4*)(dt_bias + 8 * fq), b1 = *(const f32x4*)(dt_bias + 8 * fq + 4);
                        f32x4 v0 = acc[ai][0][m][0] * rs + b0, v1 = acc[ai][0][m][1] * rs + b1;
#pragma unroll
                        for (int j = 0; j < 4; ++j) { v0[j] = softplus(v0[j]); v1[j] = softplus(v1[j]); }
                        *(f32x4*)(DT + (size_t)row * 16 + 8 * fq) = v0; *(f32x4*)(DT + (size_t)row * 16 + 8 * fq + 4) = v1;
                    }
                } else {
                    bf16_t* rowp = base + (size_t)row * ldc + colt + cl;
#pragma unroll
                    for (int bj = 0; bj < 2; ++bj) {
                        f32x4 v0 = acc[ai][bj][m][0] * rs, v1 = acc[ai][bj][m][1] * rs;
                        if (mode == 1) {
#pragma unroll
                            for (int j = 0; j < 4; ++j) { v0[j] = sigm(v0[j]); v1[j] = sigm(v1[j]); }
                        }
                        *(u32x4*)(rowp + bj * 128) = pack8(v0, v1);
                    }
                }
            }
    }
};
struct EpiAtt {
    static constexpr bool PERM = true, AFTER_DRAIN = false;
    unsigned char* ws;
    __device__ __forceinline__ void operator()(const f32x4 (&acc)[2][2][4][2], const Unit& u, int wr, int wc, int fr_, int fq_) const {
        int fr = fr_, fq = fq_; asm volatile("" : "+v"(fr), "+v"(fq));
        const int row0 = u.pm * 256 + wr * 64 + fr, col0 = u.pn * 256 + wc * 32 + 8 * fq;
        const bf16_t* GA = (const bf16_t*)(ws + WS_GA); bf16_t* MG = (bf16_t*)(ws + WS_MG);
#pragma unroll
        for (int ai = 0; ai < 2; ++ai)
#pragma unroll
            for (int m = 0; m < 4; ++m) {
                const size_t off = (size_t)(row0 + ai * 128 + m * 16) * 1024 + col0;
#pragma unroll
                for (int bj = 0; bj < 2; ++bj) {
                    f32x4 g0, g1; unpack8(*(const u32x4*)(GA + off + bj * 128), g0, g1);
                    *(u32x4*)(MG + off + bj * 128) = pack8(g0 * acc[ai][bj][m][0], g1 * acc[ai][bj][m][1]);
                }
                asm volatile("" ::: "memory");
            }
    }
};
struct EpiSsd {
    static constexpr bool PERM = true, AFTER_DRAIN = false;
    unsigned char* ws;
    __device__ __forceinline__ void operator()(const f32x4 (&acc)[2][2][4][2], const Unit& u, int wr, int wc, int fr_, int fq_) const {
        int fr = fr_, fq = fq_; asm volatile("" : "+v"(fr), "+v"(fq));
        const int row0 = u.pm * 256 + wr * 64 + fr, col0 = u.pn * 256 + wc * 32 + 8 * fq;
        const bf16_t* GS = (const bf16_t*)(ws + WS_GS); bf16_t* MG = (bf16_t*)(ws + WS_MG); const float* ssqy = (const float*)(ws + WS_SSQY);
#pragma unroll
        for (int ai = 0; ai < 2; ++ai)
#pragma unroll
            for (int m = 0; m < 4; ++m) {
                const int row = row0 + ai * 128 + m * 16; const float rs = row_rs(ssqy, row);
                const size_t off = (size_t)row * 1024 + col0;
#pragma unroll
                for (int bj = 0; bj < 2; ++bj) {
                    f32x4 g0, g1, t0, t1; unpack8(*(const u32x4*)(GS + off + bj * 128), g0, g1); unpack8(*(const u32x4*)(MG + off + bj * 128), t0, t1);
                    *(u32x4*)(MG + off + bj * 128) = pack8(t0 + g0 * (acc[ai][bj][m][0] * rs), t1 + g1 * (acc[ai][bj][m][1] * rs));
                }
                asm volatile("" ::: "memory");
            }
    }
};
struct EpiRes {
    static constexpr bool PERM = true, AFTER_DRAIN = false;
    const float* res_p; const float* res_s; float* out; unsigned char* ws; int ssq_off;
    __device__ __forceinline__ void operator()(const f32x4 (&acc)[2][2][4][2], const Unit& u, int wr, int wc, int fr_, int fq_) const {
        int fr = fr_, fq = fq_; asm volatile("" : "+v"(fr), "+v"(fq));
        const int row0 = u.pm * 256 + wr * 64 + fr, col0 = u.pn * 256 + wc * 32 + 8 * fq;
        bf16_t* OB = (bf16_t*)(ws + WS_XB); float* ssq_out = (float*)(ws + ssq_off);
#pragma unroll
        for (int ai = 0; ai < 2; ++ai)
#pragma unroll
            for (int m = 0; m < 4; ++m) {
                const int row = row0 + ai * 128 + m * 16;
                const float* rp = (u.pm < 64 ? res_p + (size_t)row * 1024 : res_s + (size_t)(row - 16384) * 1024) + col0;
                const size_t off = (size_t)row * 1024 + col0; float ss = 0.f;
#pragma unroll
                for (int bj = 0; bj < 2; ++bj) {
                    const f32x4 v0 = acc[ai][bj][m][0] + *(const f32x4*)(rp + bj * 128), v1 = acc[ai][bj][m][1] + *(const f32x4*)(rp + bj * 128 + 4);
                    *(f32x4*)(out + off + bj * 128) = v0; *(f32x4*)(out + off + bj * 128 + 4) = v1;
                    *(u32x4*)(OB + off + bj * 128) = pack8(v0, v1);
                    ss += ((v0[0] * v0[0] + v0[1] * v0[1]) + (v0[2] * v0[2] + v0[3] * v0[3])) + ((v1[0] * v1[0] + v1[1] * v1[1]) + (v1[2] * v1[2] + v1[3] * v1[3]));
                }
                ss += __shfl_xor(ss, 16); ss += __shfl_xor(ss, 32);
                if (fq == 0) ssq_out[(size_t)row * 16 + u.pn * 4 + wc] = ss;
                asm volatile("" ::: "memory");
            }
    }
};
struct EpiGlu {
    static constexpr bool PERM = true, AFTER_DRAIN = false;
    unsigned char* ws;
    __device__ __forceinline__ void operator()(const f32x4 (&acc)[2][2][4][2], const Unit& u, int wr, int wc, int fr_, int fq_) const {
        int fr = fr_, fq = fq_; asm volatile("" : "+v"(fr), "+v"(fq));
        const int row0 = u.pm * 256 + wr * 64 + fr, col0 = u.pn * 128 + wc * 32 + 8 * fq;
        const float* ssqh = (const float*)(ws + WS_SSQH); bf16_t* ACT = (bf16_t*)(ws + WS_ACT);
#pragma unroll
        for (int ai = 0; ai < 2; ++ai)
#pragma unroll
            for (int m = 0; m < 4; ++m) {
                const int row = row0 + ai * 128 + m * 16; const float rs = row_rs(ssqh, row);
                f32x4 o[2];
#pragma unroll
                for (int n = 0; n < 2; ++n) {
                    const f32x4 g = acc[ai][0][m][n] * rs, uu = acc[ai][1][m][n] * rs;
#pragma unroll
                    for (int j = 0; j < 4; ++j) o[n][j] = g[j] * sigm(g[j]) * uu[j];
                }
                *(u32x4*)(ACT + (size_t)row * 2816 + col0) = pack8(o[0], o[1]);
                asm volatile("" ::: "memory");
            }
    }
};
}
#define GAS __attribute__((address_space(1)))
#define LAS __attribute__((address_space(3)))
typedef unsigned short bf16;
typedef unsigned v4u __attribute__((ext_vector_type(4)));
typedef float f32x4 __attribute__((ext_vector_type(4)));
typedef short bf16x8 __attribute__((ext_vector_type(8)));
typedef GAS unsigned gu32;
typedef GAS unsigned long long gu64;
#define RLX_AGENT __ATOMIC_RELAXED, __HIP_MEMORY_SCOPE_AGENT
#define LDS_WAIT() asm volatile("s_waitcnt lgkmcnt(0)" ::: "memory")
#define VM_WAIT() asm volatile("s_waitcnt vmcnt(0)" ::: "memory")
__device__ __forceinline__ unsigned long long rt() { return __builtin_amdgcn_s_memrealtime(); }
__device__ __forceinline__ unsigned f2bf(float f) { unsigned u = __builtin_bit_cast(unsigned, f); return (u + 0x7fffu + ((u >> 16) & 1u)) >> 16; }
__device__ __forceinline__ unsigned pk2(float lo, float hi) { return f2bf(lo) | (f2bf(hi) << 16); }

#define XB_TMO      128
#define XB_XCNT(j)  (256  + 64 * (j))
#define XB_XSUB(j)  (1280 + 64 * (j))
#define XB_XGEN(j)  (2304 + 64 * (j))
#define XB_TOP      3328
#define XB_TOPGEN   3392
#define XCD_BAR_WORDS 3456
#define XB_SPIN_CAP (1u << 18)

__device__ __forceinline__ unsigned xb_ld(unsigned* p)              { return __hip_atomic_load(p, __ATOMIC_RELAXED, __HIP_MEMORY_SCOPE_AGENT); }
__device__ __forceinline__ unsigned xb_add(unsigned* p, unsigned v) { return __hip_atomic_fetch_add(p, v, __ATOMIC_RELAXED, __HIP_MEMORY_SCOPE_AGENT); }
__device__ __forceinline__ unsigned xb_xcc_id() { return (unsigned)__builtin_amdgcn_s_getreg((3 << 11) | 20) & 0xFu; }
#define XB_SPIN(cond, bar) do { unsigned _sp = 0; while (cond) { __builtin_amdgcn_s_sleep(1); \
    if ((++_sp & 255u) == 0u) { if (xb_ld(&(bar)[XB_TMO])) break; if (_sp > XB_SPIN_CAP) { atomicAdd(&(bar)[XB_TMO], 1u); break; } } } } while (0)

struct XcdBarrier {
    unsigned* bar; unsigned x;
    volatile LAS unsigned* st;
};

__device__ __forceinline__ XcdBarrier xcd_barrier_post(unsigned* bar, volatile LAS unsigned* st) {
    XcdBarrier b; b.bar = bar; b.x = xb_xcc_id(); b.st = st;
    if (threadIdx.x == 0) (void)xb_add(&bar[XB_XCNT(b.x)], 1u);
    return b;
}
__device__ __forceinline__ void xcd_barrier_complete(unsigned* bar, unsigned x, unsigned& nloc, unsigned& nx) {
    const unsigned G = gridDim.x * gridDim.y * gridDim.z;
    unsigned sum, cnt, mine, sp = 0u;
    for (;;) {
        sum = 0u; cnt = 0u; mine = 0u;
#pragma unroll
        for (unsigned j = 0; j < 16; ++j) { const unsigned c = xb_ld(&bar[XB_XCNT(j)]); sum += c; cnt += (c > 0u) ? 1u : 0u; mine = (j == x) ? c : mine; }
        if (sum == G) break;
        __builtin_amdgcn_s_sleep(1);
        if ((++sp & 255u) == 0u) { if (xb_ld(&bar[XB_TMO])) break; if (sp > XB_SPIN_CAP) { atomicAdd(&bar[XB_TMO], 1u); break; } }
    }
    nloc = mine > 0u ? mine : 1u; nx = cnt > 0u ? cnt : 1u;
}

__device__ __forceinline__ void xcd_barrier(const XcdBarrier& b) {
    asm volatile("s_waitcnt vmcnt(0)" ::: "memory");
    __syncthreads();
    if (threadIdx.x == 0) {
        unsigned* bar = b.bar;
        __builtin_amdgcn_s_waitcnt(0);
        unsigned nloc = b.st[0], nx = b.st[1];
        if (nloc == 0u) { xcd_barrier_complete(bar, b.x, nloc, nx); b.st[0] = nloc; b.st[1] = nx; }
        const unsigned old = xb_add(&bar[XB_XSUB(b.x)], 1u);
        const unsigned gen = old / nloc;
        if (old + 1u == (gen + 1u) * nloc) {
            __builtin_amdgcn_fence(__ATOMIC_RELEASE, "agent");
            asm volatile("s_waitcnt vmcnt(0)" ::: "memory");
            const unsigned og = xb_add(&bar[XB_TOP], 1u);
            const unsigned tg = og / nx;
            if (og + 1u == (tg + 1u) * nx) xb_add(&bar[XB_TOPGEN], 1u);
            else XB_SPIN(xb_ld(&bar[XB_TOPGEN]) == tg, bar);
            __builtin_amdgcn_fence(__ATOMIC_ACQUIRE, "agent");
            xb_add(&bar[XB_XGEN(b.x)], 1u);
            asm volatile("s_waitcnt vmcnt(0)" ::: "memory");
        } else {
            XB_SPIN(xb_ld(&bar[XB_XGEN(b.x)]) == gen, bar);
            __builtin_amdgcn_fence(__ATOMIC_ACQUIRE, "agent");
            asm volatile("s_waitcnt vmcnt(0)" ::: "memory");
        }
    }
    __syncthreads();
}

struct Args { const float* in[24]; float* out; unsigned char* ws; int ph_lo, ph_hi, li, pad; };
struct Frame { LAS unsigned char* lds; volatile LAS unsigned* MISC; gu32* ctl; int tid, lane, wave, vcu, G; };

__device__ __forceinline__ float wave_sum(float v) {
#pragma unroll
    for (int o = 1; o < 64; o <<= 1) v += __shfl_xor(v, o);
    return v;
}
__device__ __forceinline__ float bf2f(unsigned short b) { return __uint_as_float((unsigned)b << 16); }
__device__ __forceinline__ float sigm(float x) { return __builtin_amdgcn_rcpf(1.0f + __expf(-x)); }

__device__ __forceinline__ void wconv_item(const float* W, int ldw, int K, bf16* WT, int nd0, int sc0, int nvalid, const float* g, int k0, LAS float* scr, int lane) {
    const int j = lane & 31;
#pragma unroll 8
    for (int i = 0; i < 32; ++i) { const int kk = 2 * i + (lane >> 5); float v = 0.f;
        if (j < nvalid) { v = W[(size_t)(k0 + kk) * ldw + sc0 + j]; if (g) v *= g[k0 + kk]; }
        scr[kk * 33 + j] = v; }
    LDS_WAIT(); asm volatile("" ::: "memory");
    const int c = lane & 7;
#pragma unroll
    for (int jj = 0; jj < 4; ++jj) { const int n = (lane >> 3) + 8 * jj; const LAS float* s = scr + (8 * c) * 33 + n;
        v4u o; o.x = pk2(s[0 * 33], s[1 * 33]); o.y = pk2(s[2 * 33], s[3 * 33]); o.z = pk2(s[4 * 33], s[5 * 33]); o.w = pk2(s[6 * 33], s[7 * 33]);
        *(GAS v4u*)(WT + (size_t)(nd0 + n) * K + k0 + 8 * c) = o; }
    LDS_WAIT(); asm volatile("" ::: "memory");
}
__device__ __forceinline__ void p0_convert(Frame& F, const Args& a, int l) {
    LAS float* scr = (LAS float*)(F.lds + F.wave * 16384);
    const int gw = F.vcu * NWAVES + F.wave, NGW = F.G * NWAVES;
    bf16* W_IN = (bf16*)(a.ws + WS_WIN); bf16* W_GU = (bf16*)(a.ws + WS_WGU); bf16* W_ATT = (bf16*)(a.ws + WS_WATT);
    bf16* W_SSD = (bf16*)(a.ws + WS_WSSD); bf16* W_OUT = (bf16*)(a.ws + WS_WOUT); bf16* W_DN = (bf16*)(a.ws + WS_WDN);
    constexpr int I_IN = 16 * 176, I_GU = 16 * 176, I_ATT = 8 * 32, I_SSD = 16 * 32, I_OUT = 16 * 32, I_DN = 44 * 32;
    constexpr int NITEMS = I_IN + I_GU + I_ATT + I_SSD + I_OUT + I_DN;
    for (int it = gw; it < NITEMS; it += NGW) {
        int r = it;
        if (r < I_IN) { const int kb = r / 176, nd0 = (r % 176) * 32; int sc0 = 0, nv = 32;
            if (nd0 < 3328) sc0 = nd0; else if (nd0 < 5376) sc0 = nd0 + 16; else if (nd0 == 5376) { sc0 = 3328; nv = 16; } else nv = 0;
            wconv_item(a.in[8] + (size_t)l * 1024 * 5392, 5392, 1024, W_IN, nd0, sc0, nv, a.in[7] + l * 1024, kb * 64, scr, F.lane); continue; }
        r -= I_IN;
        if (r < I_GU) { const int kb = r / 176, nd0 = (r % 176) * 32, t = nd0 >> 8, jj = nd0 & 255;
            const float* W = (jj < 128 ? a.in[20] : a.in[21]) + (size_t)l * 1024 * 2816;
            wconv_item(W, 2816, 1024, W_GU, nd0, 128 * t + (jj & 127), 32, a.in[19] + l * 1024, kb * 64, scr, F.lane); continue; }
        r -= I_GU;
        if (r < I_ATT) { const int kb = r / 32, nd0 = (r % 32) * 32; wconv_item(a.in[16] + (size_t)l * 512 * 1024, 1024, 512, W_ATT, nd0, nd0, 32, nullptr, kb * 64, scr, F.lane); continue; }
        r -= I_ATT;
        if (r < I_SSD) { const int kb = r / 32, nd0 = (r % 32) * 32; wconv_item(a.in[17] + (size_t)l * 1024 * 1024, 1024, 1024, W_SSD, nd0, nd0, 32, a.in[14] + l * 1024, kb * 64, scr, F.lane); continue; }
        r -= I_SSD;
        if (r < I_OUT) { const int kb = r / 32, nd0 = (r % 32) * 32; wconv_item(a.in[18] + (size_t)l * 1024 * 1024, 1024, 1024, W_OUT, nd0, nd0, 32, nullptr, kb * 64, scr, F.lane); continue; }
        r -= I_OUT;
        { const int kb = r / 32, nd0 = (r % 32) * 32; wconv_item(a.in[22] + (size_t)l * 2816 * 1024, 1024, 2816, W_DN, nd0, nd0, 32, nullptr, kb * 64, scr, F.lane); }
    }
    if (l == 0) {
        bf16* XB = (bf16*)(a.ws + WS_XB); float* SSQX = (float*)(a.ws + WS_SSQX);
        for (int m = gw; m < MALL; m += NGW) {
            const float* xrow = m < MP ? a.in[0] + (size_t)m * DM : a.in[1] + (size_t)(m - MP) * DM;
            const GAS f32x4* xr = (const GAS f32x4*)xrow + F.lane;
            f32x4 v[4]; float s = 0.f;
#pragma unroll
            for (int j = 0; j < 4; ++j) { v[j] = xr[64 * j]; s += (v[j].x * v[j].x + v[j].y * v[j].y) + (v[j].z * v[j].z + v[j].w * v[j].w); }
            s = wave_sum(s);
            GAS unsigned long long* o8 = (GAS unsigned long long*)(XB + (size_t)m * DM) + F.lane;
#pragma unroll
            for (int j = 0; j < 4; ++j) o8[64 * j] = (unsigned long long)pk2(v[j].x, v[j].y) | ((unsigned long long)pk2(v[j].z, v[j].w) << 32);
            if (F.lane < 16) SSQX[(size_t)m * 16 + F.lane] = F.lane == 0 ? s : 0.f;
        }
    }
}

typedef LAS unsigned short lbf;
__device__ __forceinline__ bf16x8 ldfrag(const lbf* base, int row, int ld, int k0, int lane) { return *(const LAS bf16x8*)(base + row * ld + k0 + 8 * (lane >> 4)); }
#define MFMA16(a, b, c) __builtin_amdgcn_mfma_f32_16x16x32_bf16((a), (b), (c), 0, 0, 0)
__device__ __forceinline__ int t5_bucket(int rel) {
    const int n = rel < 0 ? -rel : rel;
    const int big = 8 + (n >= 12) + (n >= 16) + (n >= 23) + (n >= 32) + (n >= 46) + (n >= 64) + (n >= 91);
    return (rel > 0 ? 16 : 0) + (n < 8 ? n : big);
}
constexpr int AT_KS = 0, AT_KLD = 72, AT_VT = 27648, AT_VLD = 200, AT_P = 53248, AT_PLD = 200, AT_TB = 104448;
template <bool SAMPLE>
__device__ __forceinline__ void attn_unit(Frame& F, const Args& a, int l, int b, int c, int g) {
    lbf* Ks = (lbf*)(F.lds + AT_KS); lbf* VT = (lbf*)(F.lds + AT_VT); lbf* Pw = (lbf*)(F.lds + AT_P) + F.wave * (16 * AT_PLD); LAS float* tb = (LAS float*)(F.lds + AT_TB);
    bf16* Qb = (bf16*)(a.ws + WS_Q); const bf16* KVb = (const bf16*)(a.ws + WS_KV);
    const int tid = F.tid, lane = F.lane, wave = F.wave;
    for (int e = tid; e < 1024; e += 512) { const int r = e >> 8, rel = (e & 255) - 192; tb[e] = a.in[6][t5_bucket(rel) * 8 + g * 4 + r]; }
    const int rowbase = SAMPLE ? MP + b * 16 : b * 4096 + c * 64;
    for (int e = tid; e < 1536; e += 512) {
        const int key = e >> 3, pc = e & 7;
        float kf[8], vf[8]; bool valid, exact = false;
#pragma unroll
        for (int j = 0; j < 8; ++j) { kf[j] = 0.f; vf[j] = 0.f; }
        if (SAMPLE) {
            valid = key < 144;
            if (key < 128) { exact = true;
                const size_t off = (((size_t)(l * 16 + b) * 128 + key) * 2 + g) * 64 + pc * 8;
                const f32x4 k0 = *(const f32x4*)(a.in[2] + off), k1 = *(const f32x4*)(a.in[2] + off + 4), v0 = *(const f32x4*)(a.in[3] + off), v1 = *(const f32x4*)(a.in[3] + off + 4);
#pragma unroll
                for (int j = 0; j < 4; ++j) { kf[j] = k0[j]; kf[4 + j] = k1[j]; vf[j] = v0[j]; vf[4 + j] = v1[j]; }
            }
        } else valid = (c - 2) * 64 + key >= 0;
        if (valid && !exact) {
            const size_t row = SAMPLE ? (size_t)(MP + b * 16 + key - 128) : (size_t)(b * 4096 + (c - 2) * 64 + key);
            const v4u kw = *(const v4u*)(KVb + row * 256 + g * 64 + pc * 8), vw = *(const v4u*)(KVb + row * 256 + 128 + g * 64 + pc * 8);
            kf[0] = __uint_as_float(kw.x << 16); kf[1] = __uint_as_float(kw.x & 0xffff0000u); kf[2] = __uint_as_float(kw.y << 16); kf[3] = __uint_as_float(kw.y & 0xffff0000u);
            kf[4] = __uint_as_float(kw.z << 16); kf[5] = __uint_as_float(kw.z & 0xffff0000u); kf[6] = __uint_as_float(kw.w << 16); kf[7] = __uint_as_float(kw.w & 0xffff0000u);
            vf[0] = __uint_as_float(vw.x << 16); vf[1] = __uint_as_float(vw.x & 0xffff0000u); vf[2] = __uint_as_float(vw.y << 16); vf[3] = __uint_as_float(vw.y & 0xffff0000u);
            vf[4] = __uint_as_float(vw.z << 16); vf[5] = __uint_as_float(vw.z & 0xffff0000u); vf[6] = __uint_as_float(vw.w << 16); vf[7] = __uint_as_float(vw.w & 0xffff0000u);
        }
        v4u kp; kp.x = pk2(kf[0], kf[1]); kp.y = pk2(kf[2], kf[3]); kp.z = pk2(kf[4], kf[5]); kp.w = pk2(kf[6], kf[7]);
        *(LAS v4u*)(Ks + key * AT_KLD + pc * 8) = kp;
#pragma unroll
        for (int j = 0; j < 8; ++j) VT[(pc * 8 + j) * AT_VLD + key] = (unsigned short)f2bf(vf[j]);
        float* ko = nullptr; float* vo = nullptr;
        if (SAMPLE) { if (key >= 16 && key < 144) { const size_t o = (((size_t)(l * 16 + b) * 128 + key - 16) * 2 + g) * 64 + pc * 8; ko = a.out + O_KS + o; vo = a.out + O_VS + o; } }
        else if (c >= 62 && key >= 128) { const size_t o = (((size_t)(l * 4 + b) * 128 + (c - 62) * 64 + key - 128) * 2 + g) * 64 + pc * 8; ko = a.out + O_KP + o; vo = a.out + O_VP + o; }
        if (ko) { *(f32x4*)ko = (f32x4){kf[0], kf[1], kf[2], kf[3]}; *(f32x4*)(ko + 4) = (f32x4){kf[4], kf[5], kf[6], kf[7]};
                  *(f32x4*)vo = (f32x4){vf[0], vf[1], vf[2], vf[3]}; *(f32x4*)(vo + 4) = (f32x4){vf[4], vf[5], vf[6], vf[7]}; }
    }
    __syncthreads();
    const int npass = SAMPLE ? (wave < 4 ? 1 : 0) : 2;
    const int r = SAMPLE ? (wave & 3) : (wave >> 1);
    const float sink = a.in[15][l * 8 + g * 4 + r];
    const int q4 = lane >> 4, fr = lane & 15;
    for (int ps = 0; ps < npass; ++ps) {
        const int i0 = SAMPLE ? 0 : (wave & 1) * 32 + ps * 16;
        const size_t qoff = (size_t)(rowbase + i0 + fr) * 512 + (g * 4 + r) * 64;
        const bf16x8 qf0 = *(const bf16x8*)(Qb + qoff + 8 * q4), qf1 = *(const bf16x8*)(Qb + qoff + 32 + 8 * q4);
        f32x4 s[12];
#pragma unroll
        for (int kt = 0; kt < 12; ++kt) { s[kt] = (f32x4){0.f, 0.f, 0.f, 0.f};
            s[kt] = MFMA16(ldfrag(Ks, 16 * kt + fr, AT_KLD, 0, lane), qf0, s[kt]);
            s[kt] = MFMA16(ldfrag(Ks, 16 * kt + fr, AT_KLD, 32, lane), qf1, s[kt]); }
        const int jlo = SAMPLE ? 0 : (c >= 2 ? 0 : (2 - c) * 64), jhi = SAMPLE ? 144 : 192;
        float mx = -3.0e38f;
#pragma unroll
        for (int kt = 0; kt < 12; ++kt)
#pragma unroll
            for (int ii = 0; ii < 4; ++ii) { const int key = 16 * kt + 4 * q4 + ii;
                float v = s[kt][ii] * 0.125f + tb[r * 256 + key - (i0 + fr) + 64];
                v = (key >= jlo && key < jhi) ? v : -1.0e30f; s[kt][ii] = v; mx = fmaxf(mx, v); }
        mx = fmaxf(mx, __shfl_xor(mx, 16)); mx = fmaxf(mx, __shfl_xor(mx, 32)); mx = fmaxf(mx, sink);
        float sum = 0.f;
#pragma unroll
        for (int kt = 0; kt < 12; ++kt)
#pragma unroll
            for (int ii = 0; ii < 4; ++ii) { const float p = __expf(s[kt][ii] - mx); s[kt][ii] = p; sum += p; }
        sum += __shfl_xor(sum, 16); sum += __shfl_xor(sum, 32);
        const float inv = 1.0f / (sum + __expf(sink - mx));
#pragma unroll
        for (int kt = 0; kt < 12; ++kt) {
            unsigned long long w = (unsigned long long)pk2(s[kt][0] * inv, s[kt][1] * inv) | ((unsigned long long)pk2(s[kt][2] * inv, s[kt][3] * inv) << 32);
            *(LAS unsigned long long*)(Pw + fr * AT_PLD + 16 * kt + 4 * q4) = w; }
        LDS_WAIT(); asm volatile("" ::: "memory");
        f32x4 o[4];
#pragma unroll
        for (int dt = 0; dt < 4; ++dt) o[dt] = (f32x4){0.f, 0.f, 0.f, 0.f};
#pragma unroll
        for (int kk = 0; kk < 6; ++kk) { const bf16x8 pa = ldfrag(Pw, fr, AT_PLD, kk * 32, lane);
#pragma unroll
            for (int dt = 0; dt < 4; ++dt) o[dt] = MFMA16(pa, ldfrag(VT, 16 * dt + fr, AT_VLD, kk * 32, lane), o[dt]); }
#pragma unroll
        for (int dt = 0; dt < 4; ++dt)
#pragma unroll
            for (int ii = 0; ii < 4; ++ii) Qb[(size_t)(rowbase + i0 + 4 * q4 + ii) * 512 + (g * 4 + r) * 64 + 16 * dt + fr] = (unsigned short)f2bf(o[dt][ii]);
        LDS_WAIT(); asm volatile("" ::: "memory");
    }
    __syncthreads();
}

constexpr int SD_CM = 0, SD_BM = 17408, SD_BT = 34816, SD_XT = 53248, SD_XS = 62464, SD_GM = 71680, SD_HB = 80896, SD_XF = 98304, SD_SC = 114944;
constexpr int SD_LDN = 136, SD_LDL = 72, SD_LDF = 65;
template <bool SAMPLE>
__device__ __forceinline__ void ssd_unit(Frame& F, const Args& a, int l, int b, int h) {
    lbf* Cm = (lbf*)(F.lds + SD_CM); lbf* Bm = (lbf*)(F.lds + SD_BM); lbf* BT = (lbf*)(F.lds + SD_BT); lbf* XT = (lbf*)(F.lds + SD_XT); lbf* XS = (lbf*)(F.lds + SD_XS);
    lbf* Gm = (lbf*)(F.lds + SD_GM); lbf* Hb = (lbf*)(F.lds + SD_HB); LAS float* xf = (LAS float*)(F.lds + SD_XF);
    LAS float* dts = (LAS float*)(F.lds + SD_SC); LAS float* acs = dts + 64; LAS float* wsc = dts + 128; LAS float* ssqp = dts + 192;
    const int tid = F.tid, lane = F.lane, wave = F.wave, q4 = lane >> 4, fr = lane & 15, g = h >> 3;
    const bf16* XBC = (const bf16*)(a.ws + WS_XBC); bf16* Zb = (bf16*)(a.ws + WS_Z); const float* DT = (const float*)(a.ws + WS_DT); float* SSQY = (float*)(a.ws + WS_SSQY);
    const float a_h = -__expf(a.in[12][l * 16 + h]), Dh = a.in[13][l * 16 + h];
    const int L = SAMPLE ? 16 : 64, nchunk = SAMPLE ? 1 : 64;
    const int pt = wave & 3, nq = wave >> 2;
    float* stout = a.out + (SAMPLE ? O_SS + ((size_t)(l * 16 + b) * 16 + h) * 8192 : O_SP + ((size_t)(l * 4 + b) * 16 + h) * 8192);
    f32x4 hacc[4];
#pragma unroll
    for (int j = 0; j < 4; ++j) {
#pragma unroll
        for (int i = 0; i < 4; ++i) hacc[j][i] = SAMPLE ? a.in[5][(((size_t)(l * 16 + b) * 16 + h) * 64 + 16 * pt + 4 * q4 + i) * 128 + 16 * (4 * nq + j) + fr] : 0.f;
    }
#pragma unroll
    for (int j = 0; j < 4; ++j)
#pragma unroll
        for (int i = 0; i < 4; ++i) Hb[(16 * pt + 4 * q4 + i) * SD_LDN + 16 * (4 * nq + j) + fr] = (unsigned short)f2bf(hacc[j][i]);
    const int cg = tid % 80, rsg = tid / 80;
    const int ccol = cg < 16 ? h * 64 + cg * 4 : (cg < 48 ? 1024 + g * 128 + (cg - 16) * 4 : 1280 + g * 128 + (cg - 48) * 4);
    float cw[4][4], cb[4];
    if (tid < 320) {
#pragma unroll
        for (int w = 0; w < 4; ++w) { const f32x4 t = *(const f32x4*)(a.in[9] + (size_t)(l * 4 + w) * 1536 + ccol); cw[w][0] = t[0]; cw[w][1] = t[1]; cw[w][2] = t[2]; cw[w][3] = t[3]; }
        { const f32x4 t = *(const f32x4*)(a.in[10] + (size_t)l * 1536 + ccol); cb[0] = t[0]; cb[1] = t[1]; cb[2] = t[2]; cb[3] = t[3]; }
    }
    for (int c = 0; c < nchunk; ++c) {
        const int r0 = SAMPLE ? MP + b * 16 : b * 4096 + c * 64;
        if (wave == 0) {
            const float dtv = lane < L ? DT[(size_t)(r0 + lane) * 16 + h] : 0.f;
            float ac = dtv * a_h;
#pragma unroll
            for (int o = 1; o < 64; o <<= 1) { const float t = __shfl_up(ac, o); if (lane >= o) ac += t; }
            const float tot = __shfl(ac, 63);
            dts[lane] = dtv; acs[lane] = ac; wsc[lane] = dtv * __expf(tot - ac);
        }
        __syncthreads();
        if (tid < 320) {
            const int l0 = rsg * 16;
            float win[3][4], cur[4];
#define SSD_LOADROW(dst, lr_) do { const int lr__ = (lr_); dst[0] = 0.f; dst[1] = 0.f; dst[2] = 0.f; dst[3] = 0.f; \
                if (SAMPLE && lr__ < 0) { const f32x4 h0 = *(const f32x4*)(a.in[4] + ((size_t)(l * 16 + b) * 3 + (lr__ + 3)) * 1536 + ccol); dst[0] = h0[0]; dst[1] = h0[1]; dst[2] = h0[2]; dst[3] = h0[3]; } \
                else if (SAMPLE ? (lr__ < 16) : (c * 64 + lr__ >= 0)) { const unsigned long long w = *(const unsigned long long*)(XBC + (size_t)(r0 + lr__) * 1536 + ccol); \
                    dst[0] = __uint_as_float((unsigned)w << 16); dst[1] = __uint_as_float((unsigned)w & 0xffff0000u); dst[2] = __uint_as_float((unsigned)(w >> 32) << 16); dst[3] = __uint_as_float((unsigned)(w >> 32) & 0xffff0000u); } } while (0)
            SSD_LOADROW(win[0], l0 - 3); SSD_LOADROW(win[1], l0 - 2); SSD_LOADROW(win[2], l0 - 1);
#pragma unroll 4
            for (int jr = 0; jr < 16; ++jr) {
                const int lr = l0 + jr; float o[4];
                SSD_LOADROW(cur, lr);
#pragma unroll
                for (int e = 0; e < 4; ++e) { float v = cb[e] + cw[0][e] * win[0][e] + cw[1][e] * win[1][e] + cw[2][e] * win[2][e] + cw[3][e] * cur[e];
                    v = v * sigm(v); o[e] = (lr < L) ? v : 0.f; win[0][e] = win[1][e]; win[1][e] = win[2][e]; win[2][e] = cur[e]; }
                asm volatile("" ::: "memory");
                if (cg < 16) { const float wl = wsc[lr];
#pragma unroll
                    for (int e = 0; e < 4; ++e) { const int p = cg * 4 + e; xf[lr * SD_LDF + p] = o[e]; XT[p * SD_LDL + lr] = (unsigned short)f2bf(o[e]); XS[p * SD_LDL + lr] = (unsigned short)f2bf(o[e] * wl); } }
                else if (cg < 48) { const int n0 = (cg - 16) * 4;
                    *(LAS unsigned long long*)(Bm + lr * SD_LDN + n0) = (unsigned long long)pk2(o[0], o[1]) | ((unsigned long long)pk2(o[2], o[3]) << 32);
#pragma unroll
                    for (int e = 0; e < 4; ++e) BT[(n0 + e) * SD_LDL + lr] = (unsigned short)f2bf(o[e]); }
                else { const int n0 = (cg - 48) * 4;
                    *(LAS unsigned long long*)(Cm + lr * SD_LDN + n0) = (unsigned long long)pk2(o[0], o[1]) | ((unsigned long long)pk2(o[2], o[3]) << 32); }
            }
        }
        __syncthreads();
#pragma unroll
        for (int tt = 0; tt < 2; ++tt) { const int t = 2 * wave + tt, lt = t >> 2, st = t & 3;
            f32x4 acc = (f32x4){0.f, 0.f, 0.f, 0.f};
            if (st <= lt) {
#pragma unroll
                for (int ks = 0; ks < 4; ++ks) acc = MFMA16(ldfrag(Cm, 16 * lt + fr, SD_LDN, 32 * ks, lane), ldfrag(Bm, 16 * st + fr, SD_LDN, 32 * ks, lane), acc);
            }
            const int sidx = 16 * st + fr; const float acs_s = acs[sidx], dt_s = dts[sidx];
#pragma unroll
            for (int i = 0; i < 4; ++i) { const int lidx = 16 * lt + 4 * q4 + i;
                const float gv = (sidx <= lidx) ? acc[i] * __expf(acs[lidx] - acs_s) * dt_s : 0.f;
                Gm[lidx * SD_LDL + sidx] = (unsigned short)f2bf(gv); }
        }
        { const float dec = __expf(acs[63]);
#pragma unroll
            for (int j = 0; j < 4; ++j) { hacc[j] = hacc[j] * dec;
#pragma unroll
                for (int ks = 0; ks < 2; ++ks) hacc[j] = MFMA16(ldfrag(XS, 16 * pt + fr, SD_LDL, 32 * ks, lane), ldfrag(BT, 16 * (4 * nq + j) + fr, SD_LDL, 32 * ks, lane), hacc[j]); }
        }
        __syncthreads();
#pragma unroll
        for (int tt = 0; tt < 2; ++tt) { const int t = 2 * wave + tt, lt = t >> 2, pt2 = t & 3;
            f32x4 yd = (f32x4){0.f, 0.f, 0.f, 0.f}, yo = (f32x4){0.f, 0.f, 0.f, 0.f};
#pragma unroll
            for (int ks = 0; ks < 2; ++ks) yd = MFMA16(ldfrag(Gm, 16 * lt + fr, SD_LDL, 32 * ks, lane), ldfrag(XT, 16 * pt2 + fr, SD_LDL, 32 * ks, lane), yd);
#pragma unroll
            for (int ks = 0; ks < 4; ++ks) yo = MFMA16(ldfrag(Cm, 16 * lt + fr, SD_LDN, 32 * ks, lane), ldfrag(Hb, 16 * pt2 + fr, SD_LDN, 32 * ks, lane), yo);
            const int p = 16 * pt2 + fr;
#pragma unroll
            for (int i = 0; i < 4; ++i) { const int lidx = 16 * lt + 4 * q4 + i;
                float y = yd[i] + __expf(acs[lidx]) * yo[i] + Dh * xf[lidx * SD_LDF + p];
                float sq = 0.f;
                if (lidx < L) { bf16* zp = Zb + (size_t)(r0 + lidx) * 1024 + h * 64 + p; const float z = bf2f(*zp); y = y * (z * sigm(z)); *zp = (unsigned short)f2bf(y); sq = y * y; }
                sq += __shfl_xor(sq, 1); sq += __shfl_xor(sq, 2); sq += __shfl_xor(sq, 4); sq += __shfl_xor(sq, 8);
                if (fr == 0) ssqp[pt2 * 64 + lidx] = sq; }
        }
        __syncthreads();
#pragma unroll
        for (int j = 0; j < 4; ++j)
#pragma unroll
            for (int i = 0; i < 4; ++i) Hb[(16 * pt + 4 * q4 + i) * SD_LDN + 16 * (4 * nq + j) + fr] = (unsigned short)f2bf(hacc[j][i]);
        if (tid < L) SSQY[(size_t)(r0 + tid) * 16 + h] = (ssqp[tid] + ssqp[64 + tid]) + (ssqp[128 + tid] + ssqp[192 + tid]);
    }
#pragma unroll
    for (int j = 0; j < 4; ++j)
#pragma unroll
        for (int i = 0; i < 4; ++i) stout[(size_t)(16 * pt + 4 * q4 + i) * 128 + 16 * (4 * nq + j) + fr] = hacc[j][i];
    __syncthreads();
}

__device__ __forceinline__ void p2_mixers(Frame& F, const Args& a, int l) {
    const int v = F.vcu;
    if (v < 64) { if (MIX_EN(0)) ssd_unit<false>(F, a, l, v >> 4, v & 15); }
    else if (v < 80) { if (MIX_EN(1)) for (int h = 0; h < 16; ++h) ssd_unit<true>(F, a, l, v - 64, h); }
    else {
        const int A = v - 80;
        for (int u = A; u < 544; u += 176) {
            if (u < 512) { if (MIX_EN(2)) attn_unit<false>(F, a, l, u >> 7, (u >> 1) & 63, u & 1); }
            else if (MIX_EN(3)) attn_unit<true>(F, a, l, (u - 512) >> 1, 0, u & 1);
        }
        const bf16* XBC = (const bf16*)(a.ws + WS_XBC);
        for (int e = A * 512 + F.tid; e < 20 * 3 * 1536; e += 176 * 512) {
            const int ch = e % 1536, j = (e / 1536) % 3, s = e / 4608;
            if (s < 4) a.out[O_CP + ((size_t)(l * 4 + s) * 3 + j) * 1536 + ch] = bf2f(XBC[(size_t)(s * 4096 + 4093 + j) * 1536 + ch]);
            else a.out[O_CS + ((size_t)(l * 16 + s - 4) * 3 + j) * 1536 + ch] = bf2f(XBC[(size_t)(MP + (s - 4) * 16 + 13 + j) * 1536 + ch]);
        }
    }
}

__global__ void __launch_bounds__(NWAVES * 64, 2) enc_fwd(Args args) {
    extern __shared__ __attribute__((aligned(16))) unsigned char lds[];
    Frame F;
    F.lds = (LAS unsigned char*)lds;
    F.MISC = (volatile LAS unsigned*)(F.lds + MISC_OFF);
    F.tid = threadIdx.x; F.lane = F.tid & 63; F.wave = __builtin_amdgcn_readfirstlane(F.tid >> 6);
    F.G = gridDim.x; { const int bx = blockIdx.x; F.vcu = (F.G % 8 == 0) ? (bx % 8) * (F.G / 8) + bx / 8 : bx; }
    unsigned char* ws = args.ws;
    F.ctl = (gu32*)(ws + WS_CTL);
    for (int u = F.tid; u < (LDS_BYTES - LDSCTL_OFF) / 4; u += NWAVES * 64) ((LAS unsigned*)(F.lds + LDSCTL_OFF))[u] = 0u;
    __syncthreads();
    XcdBarrier bar; bar.bar = (unsigned*)(F.ctl + CW_BAR); bar.x = 0; bar.st = nullptr;
    if (!MK_SPLIT) bar = xcd_barrier_post((unsigned*)(F.ctl + CW_BAR), F.MISC + 8);
    const int lo = args.ph_lo, hi = args.ph_hi;
    for (int ph = lo; ph < hi; ++ph) {
        if (ph > lo && !MK_SPLIT) xcd_barrier(bar);
        { int tv = threadIdx.x; asm volatile("" : "+v"(tv)); F.tid = tv; F.lane = tv & 63; F.wave = __builtin_amdgcn_readfirstlane(tv >> 6); }
        const int l = ph / 7, k = ph % 7;
        if (PH_EN(7) && ph == NPHASE - 1) {
            const int gw = F.vcu * NWAVES + F.wave, NGW = F.G * NWAVES;
            for (int m = gw; m < MALL; m += NGW) {
                const float rs = epi::row_rs((const float*)(ws + WS_SSQX), m);
                GAS f32x4* xr = (GAS f32x4*)(args.out + (size_t)m * DM) + F.lane; const GAS f32x4* gr = (const GAS f32x4*)args.in[23] + F.lane;
#pragma unroll
                for (int j = 0; j < 4; ++j) { f32x4 v = xr[64 * j]; const f32x4 gg = gr[64 * j]; v = v * rs * gg; xr[64 * j] = v; }
            }
        } else if (PH_EN(0) && k == 0) { p0_convert(F, args, l);
        } else if (PH_EN(1) && k == 1) {
            pg8::Gemm g{(const bf16*)(ws + WS_XB), (const bf16*)(ws + WS_WIN), MALL, NU, 1024}; pg8::StaticOrder S; S.init(MALL, NU, F.G, (int)blockIdx.x);
            epi::EpiIn E{ws, args.in[11] + l * 16};
            pg8::gemm_phase<epi::EpiIn, pg8::StaticOrder, true, true>(F.lds, g, S, E);
        } else if (PH_EN(2) && k == 2) { p2_mixers(F, args, l);
        } else if (PH_EN(3) && k == 3) {
            { pg8::Gemm g{(const bf16*)(ws + WS_Q), (const bf16*)(ws + WS_WATT), MALL, 1024, 512}; pg8::StaticOrder S; S.init(MALL, 1024, F.G, (int)blockIdx.x);
              epi::EpiAtt E{ws}; pg8::gemm_phase<epi::EpiAtt, pg8::StaticOrder, true, true>(F.lds, g, S, E); }
            { pg8::Gemm g{(const bf16*)(ws + WS_Z), (const bf16*)(ws + WS_WSSD), MALL, 1024, 1024}; pg8::StaticOrder S; S.init(MALL, 1024, F.G, (int)blockIdx.x);
              epi::EpiSsd E{ws}; pg8::gemm_phase<epi::EpiSsd, pg8::StaticOrder, true, true>(F.lds, g, S, E); }
        } else if (PH_EN(4) && k == 4) {
            pg8::Gemm g{(const bf16*)(ws + WS_MG), (const bf16*)(ws + WS_WOUT), MALL, 1024, 1024}; pg8::StaticOrder S; S.init(MALL, 1024, F.G, (int)blockIdx.x);
            epi::EpiRes E{l == 0 ? args.in[0] : args.out, l == 0 ? args.in[1] : args.out + (size_t)MP * DM, args.out, ws, (int)WS_SSQH};
            pg8::gemm_phase<epi::EpiRes, pg8::StaticOrder, true, true>(F.lds, g, S, E);
        } else if (PH_EN(5) && k == 5) {
            pg8::Gemm g{(const bf16*)(ws + WS_XB), (const bf16*)(ws + WS_WGU), MALL, NU, 1024}; pg8::StaticOrder S; S.init(MALL, NU, F.G, (int)blockIdx.x);
            epi::EpiGlu E{ws}; pg8::gemm_phase<epi::EpiGlu, pg8::StaticOrder, true, true>(F.lds, g, S, E);
        } else if (PH_EN(6) && k == 6) {
            pg8::Gemm g{(const bf16*)(ws + WS_ACT), (const bf16*)(ws + WS_WDN), MALL, 1024, DFF}; pg8::StaticOrder S; S.init(MALL, 1024, F.G, (int)blockIdx.x);
            epi::EpiRes E{args.out, args.out + (size_t)MP * DM, args.out, ws, (int)WS_SSQX};
            pg8::gemm_phase<epi::EpiRes, pg8::StaticOrder, true, true>(F.lds, g, S, E);
        }
    }
}

extern "C" void kernel_launch(void* const* d_in, const int* in_sizes, int n_in, void* d_out, int out_size, void* d_ws, size_t ws_size, hipStream_t stream) {
    static int ready = 0;
    if (ready == 0) {
        if (n_in != 24 || out_size != (int)O_END || ws_size < WS_END) { fprintf(stderr, "kernel_launch: unexpected problem shape (n_in %d, out %d, ws %zu); nothing launched\n", n_in, out_size, ws_size); ready = -1; return; }
        if (hipFuncSetAttribute((const void*)enc_fwd, hipFuncAttributeMaxDynamicSharedMemorySize, LDS_BYTES) != hipSuccess) { fprintf(stderr, "kernel_launch: hipFuncSetAttribute failed\n"); ready = -1; return; }
        (void)hipGetLastError();
        ready = 1;
    }
    if (ready < 0) return;
    if (hipMemsetAsync((char*)d_ws + WS_CTL, 0, CTL_ZERO_BYTES, stream) != hipSuccess) { fprintf(stderr, "kernel_launch: hipMemsetAsync failed\n"); return; }
    Args a{};
    for (int i = 0; i < 24; ++i) a.in[i] = (const float*)d_in[i];
    a.out = (float*)d_out; a.ws = (unsigned char*)d_ws;
#if MK_SPLIT
    for (int ph = 0; ph < NPHASE; ++ph) { a.ph_lo = ph; a.ph_hi = ph + 1; a.li = ph; hipLaunchKernelGGL(enc_fwd, dim3(256), dim3(NWAVES * 64), LDS_BYTES, stream, a); }
#else
    a.ph_lo = 0; a.ph_hi = NPHASE; a.li = 0;
    hipLaunchKernelGGL(enc_fwd, dim3(256), dim3(NWAVES * 64), LDS_BYTES, stream, a);
#endif
    const hipError_t le = hipPeekAtLastError();
    if (le != hipSuccess) fprintf(stderr, "kernel_launch: launch failed: %s\n", hipGetErrorName(le));
}
```

```cpp
#include <hip/hip_runtime.h>
#include <cstdio>
#include <cstdint>
namespace pg8 {
#define PG8_LAS __attribute__((address_space(3)))
typedef unsigned short bf16_t;
typedef short bf16x8 __attribute__((ext_vector_type(8)));
typedef float f32x4 __attribute__((ext_vector_type(4)));
typedef unsigned u32x4 __attribute__((ext_vector_type(4)));
constexpr int BM = 256, BK = 64, HALF = 128, HTB = HALF * BK * 2  , STAGE_BYTES = 8 * HTB, NXCD = 8, WGM = 2;

__host__ __device__ __forceinline__ int lds_byte(int r, int c) { const int st = (r >> 4) * 2 + (c >> 5), rr = r & 15, cc = c & 31, ob = rr * 64 + cc * 2; return st * 1024 + (ob ^ (((ob >> 9) & 1) << 5)); }
__host__ __device__ __forceinline__ void stage_rc(int b, int& R, int& C) { const int st = b / 1024, sb = b % 1024, swz = sb ^ (((sb >> 9) & 1) << 5); R = (st >> 1) * 16 + swz / 64; C = (st & 1) * 32 + (swz % 64) / 2; }
__host__ __device__ __forceinline__ int perm32(int rho) { const int n = rho >> 4, i = rho & 15; return 8 * (i >> 2) + 4 * n + (i & 3); }

struct Unit { int pm, pn; };
struct Gemm { const bf16_t* A; const bf16_t* Bt; int M, N, K; };

struct StaticOrder {
    int nM, nN, nwg, G, c;
    __host__ __device__ void init(int M, int N, int G_, int c_) { nM = M / BM; nN = N / BM; nwg = nM * nN; G = G_; c = c_; }
    __host__ __device__ bool next(int i, Unit& u) const {
        const long L = (long)i * G + c; if (L >= nwg) return false;
        int wgid = (int)L; { const int q = nwg / NXCD, r = nwg % NXCD, xcd = wgid % NXCD, off = wgid / NXCD; wgid = (xcd < r ? xcd * (q + 1) : r * (q + 1) + (xcd - r) * q) + off; }
        const int nig = WGM * nN, gid = wgid / nig, fm = gid * WGM, gsz = (nM - fm) < WGM ? (nM - fm) : WGM;
        u.pm = fm + ((wgid % nig) % gsz); u.pn = (wgid % nig) / gsz; return true;
    }
    __device__ __forceinline__ void a_ready(const Unit&) const {}
    __device__ __forceinline__ void done(const Unit&) const {}
};

__device__ __forceinline__ unsigned cvt_pk_bf16(float lo, float hi) { unsigned r; asm volatile("v_cvt_pk_bf16_f32 %0, %1, %2" : "=v"(r) : "v"(lo), "v"(hi)); return r; }
typedef float f32x2 __attribute__((ext_vector_type(2)));
template <class Epi, class Sched, bool ALIGN_EPI = false, bool SP2 = false>
__device__ __forceinline__ void gemm_phase(PG8_LAS unsigned char* lds, const Gemm g, const Sched& S, const Epi& E) {
    int tid_ = threadIdx.x; asm volatile("" : "+v"(tid_));
    const int tid = tid_, wid = __builtin_amdgcn_readfirstlane(tid >> 6), lane = tid & 63, wr = wid >> 2, wc = wid & 3, fr = lane & 15, fq = lane >> 4;
    const int K = g.K, nt = K / BK;
    unsigned voffA[2], voffB[2];
#pragma unroll
    for (int i = 0; i < 2; ++i) { int R, C; stage_rc(tid * 16 + i * 8192, R, C); const int Rb = Epi::PERM ? ((R & ~31) + perm32(R & 31)) : R;
        voffA[i] = (unsigned)(R * K + C) * 2u; voffB[i] = (unsigned)(Rb * K + C) * 2u; }
    const size_t kstep = (size_t)(BK * 2);
    const size_t hstep = (size_t)HALF * K * 2;
    const size_t tstep = 2 * hstep;
    const unsigned ldsw = (unsigned)wid * 1024u;
    const int aoff = lds_byte(wr * 64 + fr, fq * 8), boff = lds_byte(wc * 32 + fr, fq * 8);
#define PG8_SA(b, h) (((b) * 2 + (h)) * HTB)
#define PG8_SB(b, h) ((4 + (b) * 2 + (h)) * HTB)
#define PG8_STAGE(bufoff, gbase, voff) do { _Pragma("unroll") for (int _i = 0; _i < 2; ++_i) \
        __builtin_amdgcn_global_load_lds((const unsigned*)((const char*)(gbase) + (voff)[_i]), (PG8_LAS unsigned*)(lds + (bufoff) + ldsw + _i * 8192), 16, 0, 0); } while (0)
#define PG8_LDA(dst, b, h) do { _Pragma("unroll") for (int m = 0; m < 4; ++m) _Pragma("unroll") for (int k = 0; k < 2; ++k) dst[m][k] = *(const PG8_LAS bf16x8*)(lds + PG8_SA(b, h) + aoff + m * 2048 + k * 1024); } while (0)
#define PG8_LDB(dst, b, h) do { _Pragma("unroll") for (int n = 0; n < 2; ++n) _Pragma("unroll") for (int k = 0; k < 2; ++k) dst[n][k] = *(const PG8_LAS bf16x8*)(lds + PG8_SB(b, h) + boff + n * 2048 + k * 1024); } while (0)
#define PG8_MMA(ai, bj, At, Bt) do { __builtin_amdgcn_s_setprio(1); _Pragma("unroll") for (int m = 0; m < 4; ++m) _Pragma("unroll") for (int n = 0; n < 2; ++n) _Pragma("unroll") for (int k = 0; k < 2; ++k) \
        acc[ai][bj][m][n] = __builtin_amdgcn_mfma_f32_16x16x32_bf16(Bt[n][k], At[m][k], acc[ai][bj][m][n], 0, 0, 0); __builtin_amdgcn_s_setprio(0); } while (0)
#define PG8_WAIT_V(n) asm volatile("s_waitcnt vmcnt(" #n ")" ::: "memory")
#define PG8_WAIT_L(n) asm volatile("s_waitcnt lgkmcnt(" #n ")" ::: "memory")
#define PG8_BAR __builtin_amdgcn_s_barrier()
#define PG8_SCHED __builtin_amdgcn_sched_barrier(0)
    Unit cur, nxt; int ui = 0;
    if (!S.next(0, cur)) return;
    f32x4 acc[2][2][4][2];
#pragma unroll
    for (int a = 0; a < 2; ++a)
#pragma unroll
        for (int b = 0; b < 2; ++b)
#pragma unroll
            for (int m = 0; m < 4; ++m)
#pragma unroll
                for (int n = 0; n < 2; ++n) acc[a][b][m][n] = (f32x4){0.f, 0.f, 0.f, 0.f};
    bf16x8 At[4][2], B0[2][2], B1[2][2];
    const char* cA = (const char*)g.A + (size_t)cur.pm * tstep; const char* cB = (const char*)g.Bt + (size_t)cur.pn * tstep;
    S.a_ready(cur);
    if constexpr (SP2) {
        PG8_STAGE(PG8_SB(0, 0), cB, voffB); PG8_STAGE(PG8_SB(0, 1), cB + hstep, voffB); PG8_STAGE(PG8_SA(0, 0), cA, voffA); PG8_STAGE(PG8_SA(0, 1), cA + hstep, voffA);
        if (wr == 1) PG8_BAR;
        PG8_WAIT_V(2); PG8_BAR;
        PG8_STAGE(PG8_SB(1, 0), cB + kstep, voffB); PG8_STAGE(PG8_SA(1, 0), cA + kstep, voffA); PG8_STAGE(PG8_SB(1, 1), cB + hstep + kstep, voffB);
        PG8_WAIT_V(6); PG8_BAR;
    } else {
        PG8_STAGE(PG8_SB(0, 0), cB, voffB); PG8_STAGE(PG8_SA(0, 0), cA, voffA); PG8_STAGE(PG8_SB(0, 1), cB + hstep, voffB); PG8_STAGE(PG8_SA(0, 1), cA + hstep, voffA);
        if (wr == 1) PG8_BAR;
        PG8_WAIT_V(4); PG8_BAR;
        PG8_STAGE(PG8_SB(1, 0), cB + kstep, voffB); PG8_STAGE(PG8_SA(1, 0), cA + kstep, voffA); PG8_STAGE(PG8_SB(1, 1), cB + hstep + kstep, voffB);
        PG8_WAIT_V(6); PG8_BAR;
    }
    for (;;) {
        const bool has_next = S.next(ui + 1, nxt);
        const char* nA = has_next ? (const char*)g.A + (size_t)nxt.pm * tstep : cA; const char* nB = has_next ? (const char*)g.Bt + (size_t)nxt.pn * tstep : cB;
        for (int t = 0; t < nt; t += 2) {
            const bool last = (t == nt - 2);
            const char* a1 = cA + (size_t)(t + 1) * kstep;
            const char* a2 = last ? nA : cA + (size_t)(t + 2) * kstep; const char* b2 = last ? nB : cB + (size_t)(t + 2) * kstep;
            const char* a3 = a2 + kstep; const char* b3 = b2 + kstep;
            if (last && has_next) S.a_ready(nxt);
            if constexpr (SP2) {
            PG8_LDB(B0, 0, 0); PG8_LDB(B1, 0, 1); PG8_SCHED; PG8_LDA(At, 0, 0); PG8_STAGE(PG8_SA(1, 1), a1 + hstep, voffA);
            PG8_WAIT_V(8); PG8_WAIT_L(0); PG8_BAR; PG8_MMA(0, 0, At, B0); PG8_MMA(0, 1, At, B1); PG8_BAR; PG8_SCHED;
            PG8_LDA(At, 0, 1); PG8_STAGE(PG8_SB(0, 0), b2, voffB); PG8_STAGE(PG8_SB(0, 1), b2 + hstep, voffB); PG8_STAGE(PG8_SA(0, 0), a2, voffA);
            PG8_WAIT_V(8); PG8_WAIT_L(0); PG8_BAR; PG8_MMA(1, 0, At, B0); PG8_MMA(1, 1, At, B1); PG8_BAR; PG8_SCHED;
            PG8_LDB(B0, 1, 0); PG8_LDB(B1, 1, 1); PG8_SCHED; PG8_LDA(At, 1, 0); PG8_STAGE(PG8_SA(0, 1), a2 + hstep, voffA);
            PG8_WAIT_V(8); PG8_WAIT_L(0); PG8_BAR; PG8_MMA(0, 0, At, B0); PG8_MMA(0, 1, At, B1); PG8_BAR; PG8_SCHED;
            PG8_LDA(At, 1, 1); PG8_STAGE(PG8_SB(1, 0), b3, voffB); PG8_STAGE(PG8_SB(1, 1), b3 + hstep, voffB); PG8_STAGE(PG8_SA(1, 0), a3, voffA);
            PG8_WAIT_V(8); PG8_WAIT_L(0); PG8_BAR; PG8_MMA(1, 0, At, B0); PG8_MMA(1, 1, At, B1); PG8_BAR; PG8_SCHED;
            } else {
            PG8_LDB(B0, 0, 0); PG8_SCHED; PG8_LDA(At, 0, 0); PG8_STAGE(PG8_SA(1, 1), a1 + hstep, voffA);
            PG8_WAIT_L(8); PG8_BAR; PG8_WAIT_L(0); PG8_MMA(0, 0, At, B0); PG8_BAR; PG8_SCHED;
            PG8_LDB(B1, 0, 1); PG8_STAGE(PG8_SB(0, 0), b2, voffB);
            PG8_BAR; PG8_WAIT_L(0); PG8_MMA(0, 1, At, B1); PG8_BAR;
            PG8_LDA(At, 0, 1); PG8_STAGE(PG8_SA(0, 0), a2, voffA);
            PG8_BAR; PG8_WAIT_L(0); PG8_MMA(1, 0, At, B0); PG8_BAR; PG8_SCHED;
            PG8_STAGE(PG8_SB(0, 1), b2 + hstep, voffB);
            PG8_WAIT_V(6); PG8_BAR; PG8_MMA(1, 1, At, B1); PG8_BAR;
            PG8_LDB(B0, 1, 0); PG8_SCHED; PG8_LDA(At, 1, 0); PG8_STAGE(PG8_SA(0, 1), a2 + hstep, voffA);
            PG8_WAIT_L(8); PG8_BAR; PG8_WAIT_L(0); PG8_MMA(0, 0, At, B0); PG8_BAR; PG8_SCHED;
            PG8_LDB(B1, 1, 1); PG8_STAGE(PG8_SB(1, 0), b3, voffB);
            PG8_BAR; PG8_WAIT_L(0); PG8_MMA(0, 1, At, B1); PG8_BAR;
            PG8_LDA(At, 1, 1); PG8_STAGE(PG8_SA(1, 0), a3, voffA);
            PG8_BAR; PG8_WAIT_L(0); PG8_MMA(1, 0, At, B0); PG8_BAR; PG8_SCHED;
            PG8_STAGE(PG8_SB(1, 1), b3 + hstep, voffB);
            PG8_WAIT_V(6); PG8_BAR; PG8_MMA(1, 1, At, B1); PG8_BAR;
            }
            if constexpr (Epi::HOOK_T > 0) { if (t + 2 == Epi::HOOK_T) E.mid(acc, cur, wr, wc, fr, fq); }
        }
        if constexpr (ALIGN_EPI) { if (wr == 0) PG8_BAR; }
        if constexpr (!Epi::AFTER_DRAIN) { E(acc, cur, wr, wc, fr, fq); S.done(cur); }
        if (!has_next) break;
#pragma unroll
        for (int a = 0; a < 2; ++a)
#pragma unroll
            for (int b = 0; b < 2; ++b)
#pragma unroll
                for (int m = 0; m < 4; ++m)
#pragma unroll
                    for (int n = 0; n < 2; ++n) acc[a][b][m][n] = (f32x4){0.f, 0.f, 0.f, 0.f};
        cur = nxt; cA = nA; cB = nB; ++ui;
        if constexpr (ALIGN_EPI) { if (wr == 1) PG8_BAR; }
    }
    PG8_WAIT_V(0);
    if constexpr (!ALIGN_EPI) { if (wr == 0) PG8_BAR; }
    PG8_BAR;
    if constexpr (Epi::AFTER_DRAIN) { E.fused(acc, cur, wr, wc, fr, fq, lds, wid, lane); S.done(cur); }
#undef PG8_SA
#undef PG8_SB
#undef PG8_STAGE
#undef PG8_LDA
#undef PG8_LDB
#undef PG8_MMA
#undef PG8_WAIT_V
#undef PG8_WAIT_L
#undef PG8_BAR
#undef PG8_SCHED
}
}

#ifndef MK_SPLIT
#define MK_SPLIT 0
#endif
#ifndef PH_MASK
#define PH_MASK 0x3ff
#endif
#define PH_EN(k) (((PH_MASK) >> (k)) & 1)
#ifndef MIX_MASK
#define MIX_MASK 0xf
#endif
#define MIX_EN(k) (((MIX_MASK) >> (k)) & 1)
#ifndef PROBE_MASK
#define PROBE_MASK 0
#endif
#ifndef SUBPROBE
#define SUBPROBE 0
#endif
#ifndef PROBE_K
#define PROBE_K 4
#endif
constexpr int NWAVES = 8;
constexpr int MP = 16384, MS = 256, MALL = MP + MS, DM = 1024, NU = 5632, DFF = 2816;
constexpr int NPHASE = 19;
constexpr size_t KiB = 1024, MiB = 1u << 20;
constexpr size_t WS_CTL = 0, CTL_ZERO_BYTES = 1 * MiB;
constexpr size_t WS_SSQX = 1 * MiB, WS_SSQY = WS_SSQX + 1280 * KiB, WS_SSQH = WS_SSQY + 1280 * KiB, WS_DT = WS_SSQH + 1280 * KiB;
constexpr size_t WS_WIN = 6 * MiB, WS_WGU = WS_WIN + 11 * MiB, WS_WATT = WS_WGU + 11 * MiB, WS_WSSD = WS_WATT + 1 * MiB, WS_WOUT = WS_WSSD + 2 * MiB, WS_WDN = WS_WOUT + 2 * MiB;
constexpr size_t WS_XB = WS_WDN + 5632 * KiB;
constexpr size_t WS_Q = WS_XB + (size_t)MALL * 1024 * 2;
constexpr size_t WS_KV = WS_Q + (size_t)MALL * 1536 * 2;
constexpr int OY_LD = 1536, OY_Z = 512;
constexpr size_t WS_XBC = WS_KV + (size_t)MALL * 256 * 2;
constexpr size_t WS_GA = WS_XBC + (size_t)MALL * 1536 * 2;
constexpr size_t WS_GS = WS_GA + (size_t)MALL * 1024 * 2;
constexpr size_t WS_END = WS_GS + (size_t)MALL * 1024 * 2;
constexpr size_t OUT_CX_BYTES = 14 * MiB, WS_SEGD = 512 * KiB;
static_assert(OUT_CX_BYTES + (size_t)MALL * 1536 * 2 <= (size_t)MALL * 1024 * 4 && (size_t)64 * 7 * 8192 * 4 <= OUT_CX_BYTES, "d_out scratch map");
constexpr size_t OUT_SEGE_UNUSED = 0;
constexpr size_t WS_MG = WS_XBC;
constexpr size_t WS_ACT = WS_Q;
static_assert(WS_END <= 256 * MiB, "d_ws map");
static_assert(WS_ACT + (size_t)MALL * DFF * 2 <= WS_GA, "ACT overlay");
static_assert(WS_XB % 256 == 0 && WS_Q % 256 == 0 && WS_KV % 256 == 0 && WS_XBC % 256 == 0 && WS_GA % 256 == 0, "align");
constexpr int CW_BAR = 4096;
constexpr size_t O_Y = 0, O_KP = 17039360, O_VP = 17170432, O_CP = 17301504, O_SP = 17338368, O_KS = 18386944, O_VS = 18911232, O_CS = 19435520, O_SS = 19582976, O_END = 23777280;
constexpr int RING_BYTES = 131072, LDS_BYTES = 163840, LDSCTL_OFF = LDS_BYTES - 4096, MISC_OFF = LDSCTL_OFF + 320;


__device__ __forceinline__ float bperm_f(float v, int src_lane) { return __int_as_float(__builtin_amdgcn_ds_bpermute(src_lane << 2, __float_as_int(v))); }
__device__ __forceinline__ float shx(float v, int m, int lane) { return bperm_f(v, lane ^ m); }

namespace epi {
using pg8::bf16_t; using pg8::f32x4; using pg8::u32x4; using pg8::Unit; using pg8::cvt_pk_bf16;
__device__ __forceinline__ float bflo(unsigned w) { return __uint_as_float(w << 16); }
__device__ __forceinline__ float bfhi(unsigned w) { return __uint_as_float(w & 0xffff0000u); }
__device__ __forceinline__ float sigm(float x) { return __builtin_amdgcn_rcpf(1.0f + __expf(-x)); }
__device__ __forceinline__ float row_rs(const float* ssq, int row) {
    const f32x4* p = (const f32x4*)(ssq + (size_t)row * 16);
    const f32x4 a = p[0], b = p[1], c = p[2], d = p[3];
    const float s = (((a[0] + a[1]) + (a[2] + a[3])) + ((b[0] + b[1]) + (b[2] + b[3]))) + (((c[0] + c[1]) + (c[2] + c[3])) + ((d[0] + d[1]) + (d[2] + d[3])));
    return rsqrtf(s * (1.0f / 1024.0f) + 1e-6f);
}
__device__ __forceinline__ u32x4 pack8(const f32x4 v0, const f32x4 v1) {
    u32x4 w; w.x = cvt_pk_bf16(v0[0], v0[1]); w.y = cvt_pk_bf16(v0[2], v0[3]); w.z = cvt_pk_bf16(v1[0], v1[1]); w.w = cvt_pk_bf16(v1[2], v1[3]); return w;
}
__device__ __forceinline__ void unpack8(const u32x4 w, f32x4& v0, f32x4& v1) {
    v0 = (f32x4){bflo(w.x), bfhi(w.x), bflo(w.y), bfhi(w.y)}; v1 = (f32x4){bflo(w.z), bfhi(w.z), bflo(w.w), bfhi(w.w)};
}
__device__ __forceinline__ float softplus(float x) { return fmaxf(x, 0.f) + log1pf(__expf(-fabsf(x))); }


#define EPI_RSL ((__attribute__((address_space(3))) float*)(uintptr_t)131072)
__device__ __forceinline__ void stage_rs(const float* ssq, const Unit& u, int wr, int wc, int fr, int fq) {
    const int tid = (wr * 4 + wc) * 64 + fq * 16 + fr;
    if (tid < 256) EPI_RSL[tid] = row_rs(ssq, u.pm * 256 + tid);
    asm volatile("s_waitcnt lgkmcnt(0)" ::: "memory"); __builtin_amdgcn_s_barrier(); asm volatile("" ::: "memory");
}

struct EpiIn {
    static constexpr bool PERM = true, AFTER_DRAIN = false; static constexpr int HOOK_T = 0;
    unsigned char* ws; const float* dt_bias;
    __device__ __forceinline__ void operator()(const f32x4 (&acc)[2][2][4][2], const Unit& u, int wr, int wc, int fr_, int fq_) const {
        int fr = fr_, fq = fq_; asm volatile("" : "+v"(fr), "+v"(fq));
        const int pn = u.pn, row0 = u.pm * 256 + wr * 64 + fr, cl = wc * 32 + 8 * fq;
        float* DT = (float*)(ws + WS_DT);
        stage_rs((const float*)(ws + WS_SSQX), u, wr, wc, fr, fq);
        size_t boff = WS_Q; int ldc = 512, colt = 0, mode = 0;
        if (pn < 2) { boff = WS_Q; ldc = OY_LD; colt = pn * 256; }
        else if (pn == 2) { boff = WS_KV; ldc = 256; colt = 0; }
        else if (pn < 7) { boff = WS_Q; ldc = OY_LD; colt = OY_Z + (pn - 3) * 256; }
        else if (pn < 13) { boff = WS_XBC; ldc = 1536; colt = (pn - 7) * 256; }
        else if (pn < 17) { boff = WS_GA; ldc = 1024; colt = (pn - 13) * 256; mode = 1; }
        else if (pn < 21) { boff = WS_GS; ldc = 1024; colt = (pn - 17) * 256; mode = 1; }
        else mode = 2;
        bf16_t* base = (bf16_t*)(ws + boff);
#pragma unroll
        for (int ai = 0; ai < 2; ++ai)
#pragma unroll
            for (int m = 0; m < 4; ++m) {
                const int row = row0 + ai * 128 + m * 16; const float rs = EPI_RSL[wr * 64 + fr + ai * 128 + m * 16];
                if (mode == 2) {
                    if (wc == 0 && fq < 2) {
                        const f32x4 b0 = *(const f32x4*)(dt_bias + 8 * fq), b1 = *(const f32x4*)(dt_bias + 8 * fq + 4);
                        f32x4 v0 = acc[ai][0][m][0] * rs + b0, v1 = acc[ai][0][m][1] * rs + b1;
#pragma unroll
                        for (int j = 0; j < 4; ++j) { v0[j] = softplus(v0[j]); v1[j] = softplus(v1[j]); }
                        *(f32x4*)(DT + (size_t)row * 16 + 8 * fq) = v0; *(f32x4*)(DT + (size_t)row * 16 + 8 * fq + 4) = v1;
                    }
                } else {
                    bf16_t* rowp = base + (size_t)row * ldc + colt + cl;
#pragma unroll
                    for (int bj = 0; bj < 2; ++bj) {
                        f32x4 v0 = acc[ai][bj][m][0] * rs, v1 = acc[ai][bj][m][1] * rs;
                        if (mode == 1) {
#pragma unroll
                            for (int j = 0; j < 4; ++j) { v0[j] = sigm(v0[j]); v1[j] = sigm(v1[j]); }
                        }
                        *(u32x4*)(rowp + bj * 128) = pack8(v0, v1);
                    }
                }
            }
    }
};
struct EpiMerge {
    static constexpr bool PERM = true, AFTER_DRAIN = false; static constexpr int HOOK_T = 8;
    unsigned char* ws;
    __device__ __forceinline__ void mid(f32x4 (&acc)[2][2][4][2], const Unit& u, int wr, int wc, int fr_, int fq_) const {
        int fr = fr_, fq = fq_; asm volatile("" : "+v"(fr), "+v"(fq));
        const int row0 = u.pm * 256 + wr * 64 + fr, col0 = u.pn * 256 + wc * 32 + 8 * fq;
        const bf16_t* GA = (const bf16_t*)(ws + WS_GA); const bf16_t* GS = (const bf16_t*)(ws + WS_GS);
#pragma unroll
        for (int ai = 0; ai < 2; ++ai) {
            u32x4 aq[4][2], sq[4][2];
#pragma unroll
            for (int m = 0; m < 4; ++m)
#pragma unroll
                for (int bj = 0; bj < 2; ++bj) { const size_t off = (size_t)(row0 + ai * 128 + m * 16) * 1024 + col0 + bj * 128; aq[m][bj] = *(const u32x4*)(GA + off); sq[m][bj] = *(const u32x4*)(GS + off); }
            asm volatile("" ::: "memory");
#pragma unroll
            for (int m = 0; m < 4; ++m) {
                const float rs = EPI_RSL[wr * 64 + fr + ai * 128 + m * 16];
#pragma unroll
                for (int bj = 0; bj < 2; ++bj) {
                    f32x4 a0, a1, s0, s1; unpack8(aq[m][bj], a0, a1); unpack8(sq[m][bj], s0, s1);
#pragma unroll
                    for (int j = 0; j < 4; ++j) { acc[ai][bj][m][0][j] *= a0[j] * __builtin_amdgcn_rcpf(fmaxf(s0[j] * rs, 1e-30f)); acc[ai][bj][m][1][j] *= a1[j] * __builtin_amdgcn_rcpf(fmaxf(s1[j] * rs, 1e-30f)); }
                }
            }
            asm volatile("" ::: "memory");
        }
    }
    __device__ __forceinline__ void operator()(const f32x4 (&acc)[2][2][4][2], const Unit& u, int wr, int wc, int fr_, int fq_) const {
        int fr = fr_, fq = fq_; asm volatile("" : "+v"(fr), "+v"(fq));
        const int row0 = u.pm * 256 + wr * 64 + fr, col0 = u.pn * 256 + wc * 32 + 8 * fq;
        const bf16_t* GS = (const bf16_t*)(ws + WS_GS); bf16_t* MG = (bf16_t*)(ws + WS_MG);
#pragma unroll
        for (int ai = 0; ai < 2; ++ai) {
            u32x4 sq[4][2];
#pragma unroll
            for (int m = 0; m < 4; ++m)
#pragma unroll
                for (int bj = 0; bj < 2; ++bj) sq[m][bj] = *(const u32x4*)(GS + (size_t)(row0 + ai * 128 + m * 16) * 1024 + col0 + bj * 128);
            asm volatile("" ::: "memory");
#pragma unroll
            for (int m = 0; m < 4; ++m) {
                const float rs = EPI_RSL[wr * 64 + fr + ai * 128 + m * 16];
                const size_t off = (size_t)(row0 + ai * 128 + m * 16) * 1024 + col0;
#pragma unroll
                for (int bj = 0; bj < 2; ++bj) {
                    f32x4 s0, s1; unpack8(sq[m][bj], s0, s1);
                    *(u32x4*)(MG + off + bj * 128) = pack8(acc[ai][bj][m][0] * (s0 * rs), acc[ai][bj][m][1] * (s1 * rs));
                }
            }
            asm volatile("" ::: "memory");
        }
    }
};
struct EpiRes {
    static constexpr bool PERM = true, AFTER_DRAIN = false; static constexpr int HOOK_T = 0;
    unsigned char* ws; int ssq_off;
    __device__ __forceinline__ void operator()(const f32x4 (&acc)[2][2][4][2], const Unit& u, int wr, int wc, int fr_, int fq_) const {
        int fr = fr_, fq = fq_; asm volatile("" : "+v"(fr), "+v"(fq));
        const int row0 = u.pm * 256 + wr * 64 + fr, col0 = u.pn * 256 + wc * 32 + 8 * fq;
        bf16_t* XB = (bf16_t*)(ws + WS_XB); float* ssq_out = (float*)(ws + ssq_off);
#pragma unroll
        for (int ai = 0; ai < 2; ++ai) {
            u32x4 rq[4][2];
#pragma unroll
            for (int m = 0; m < 4; ++m)
#pragma unroll
                for (int bj = 0; bj < 2; ++bj) rq[m][bj] = *(const u32x4*)(XB + (size_t)(row0 + ai * 128 + m * 16) * 1024 + col0 + bj * 128);
            asm volatile("" ::: "memory");
#pragma unroll
            for (int m = 0; m < 4; ++m) {
                const int row = row0 + ai * 128 + m * 16;
                const size_t off = (size_t)row * 1024 + col0; float ss = 0.f;
#pragma unroll
                for (int bj = 0; bj < 2; ++bj) {
                    f32x4 r0, r1; unpack8(rq[m][bj], r0, r1);
                    const f32x4 v0 = acc[ai][bj][m][0] + r0, v1 = acc[ai][bj][m][1] + r1;
                    *(u32x4*)(XB + off + bj * 128) = pack8(v0, v1);
                    ss += ((v0[0] * v0[0] + v0[1] * v0[1]) + (v0[2] * v0[2] + v0[3] * v0[3])) + ((v1[0] * v1[0] + v1[1] * v1[1]) + (v1[2] * v1[2] + v1[3] * v1[3]));
                }
                { const int ln_ = fq * 16 + fr; ss += shx(ss, 16, ln_); ss += shx(ss, 32, ln_); }
                if (fq == 0) ssq_out[(size_t)row * 16 + u.pn * 4 + wc] = ss;
            }
            asm volatile("" ::: "memory");
        }
    }
};
struct EpiGlu {
    static constexpr bool PERM = true, AFTER_DRAIN = false; static constexpr int HOOK_T = 0;
    unsigned char* ws;
    __device__ __forceinline__ void operator()(const f32x4 (&acc)[2][2][4][2], const Unit& u, int wr, int wc, int fr_, int fq_) const {
        int fr = fr_, fq = fq_; asm volatile("" : "+v"(fr), "+v"(fq));
        const int row0 = u.pm * 256 + wr * 64 + fr, col0 = u.pn * 128 + wc * 32 + 8 * fq;
        bf16_t* ACT = (bf16_t*)(ws + WS_ACT);
        stage_rs((const float*)(ws + WS_SSQH), u, wr, wc, fr, fq);
#pragma unroll
        for (int ai = 0; ai < 2; ++ai)
#pragma unroll
            for (int m = 0; m < 4; ++m) {
                const int row = row0 + ai * 128 + m * 16; const float rs = EPI_RSL[wr * 64 + fr + ai * 128 + m * 16];
                f32x4 o[2];
#pragma unroll
                for (int n = 0; n < 2; ++n) {
                    const f32x4 g = acc[ai][0][m][n] * rs, uu = acc[ai][1][m][n] * rs;
#pragma unroll
                    for (int j = 0; j < 4; ++j) o[n][j] = g[j] * sigm(g[j]) * uu[j];
                }
                *(u32x4*)(ACT + (size_t)row * 2816 + col0) = pack8(o[0], o[1]);
                asm volatile("" ::: "memory");
            }
    }
};
}
#define GAS __attribute__((address_space(1)))
#define LAS __attribute__((address_space(3)))
typedef unsigned short bf16;
typedef unsigned v4u __attribute__((ext_vector_type(4)));
typedef float f32x4 __attribute__((ext_vector_type(4)));
typedef short bf16x8 __attribute__((ext_vector_type(8)));
typedef GAS unsigned gu32;
typedef GAS unsigned long long gu64;
#define RLX_AGENT __ATOMIC_RELAXED, __HIP_MEMORY_SCOPE_AGENT
#define LDS_WAIT() asm volatile("s_waitcnt lgkmcnt(0)" ::: "memory")
#define VM_WAIT() asm volatile("s_waitcnt vmcnt(0)" ::: "memory")
__device__ __forceinline__ unsigned long long rt() { return __builtin_amdgcn_s_memrealtime(); }
__device__ __forceinline__ unsigned f2bf(float f) { unsigned u = __builtin_bit_cast(unsigned, f); return (u + 0x7fffu + ((u >> 16) & 1u)) >> 16; }
__device__ __forceinline__ unsigned pk2(float lo, float hi) { return f2bf(lo) | (f2bf(hi) << 16); }

#define XB_TMO      128
#define XB_XCNT(j)  (256  + 64 * (j))
#define XB_XSUB(j)  (1280 + 64 * (j))
#define XB_XGEN(j)  (2304 + 64 * (j))
#define XB_TOP      3328
#define XB_TOPGEN   3392
#define XCD_BAR_WORDS 3456
#define XB_SPIN_CAP (1u << 18)

__device__ __forceinline__ unsigned xb_ld(unsigned* p)              { return __hip_atomic_load(p, __ATOMIC_RELAXED, __HIP_MEMORY_SCOPE_AGENT); }
__device__ __forceinline__ unsigned xb_add(unsigned* p, unsigned v) { return __hip_atomic_fetch_add(p, v, __ATOMIC_RELAXED, __HIP_MEMORY_SCOPE_AGENT); }
__device__ __forceinline__ unsigned xb_xcc_id() { return (unsigned)__builtin_amdgcn_s_getreg((3 << 11) | 20) & 0xFu; }
#define XB_SPIN(cond, bar) do { unsigned _sp = 0; while (cond) { __builtin_amdgcn_s_sleep(1); \
    if ((++_sp & 255u) == 0u) { if (xb_ld(&(bar)[XB_TMO])) break; if (_sp > XB_SPIN_CAP) { atomicAdd(&(bar)[XB_TMO], 1u); break; } } } } while (0)

struct XcdBarrier {
    unsigned* bar; unsigned x;
    volatile LAS unsigned* st;
};

__device__ __forceinline__ XcdBarrier xcd_barrier_post(unsigned* bar, volatile LAS unsigned* st) {
    XcdBarrier b; b.bar = bar; b.x = xb_xcc_id(); b.st = st;
    if (threadIdx.x == 0) (void)xb_add(&bar[XB_XCNT(b.x)], 1u);
    return b;
}
__device__ __forceinline__ void xcd_barrier_complete(unsigned* bar, unsigned x, unsigned& nloc, unsigned& nx) {
    const unsigned G = gridDim.x * gridDim.y * gridDim.z;
    unsigned sum, cnt, mine, sp = 0u;
    for (;;) {
        sum = 0u; cnt = 0u; mine = 0u;
#pragma unroll
        for (unsigned j = 0; j < 16; ++j) { const unsigned c = xb_ld(&bar[XB_XCNT(j)]); sum += c; cnt += (c > 0u) ? 1u : 0u; mine = (j == x) ? c : mine; }
        if (sum == G) break;
        __builtin_amdgcn_s_sleep(1);
        if ((++sp & 255u) == 0u) { if (xb_ld(&bar[XB_TMO])) break; if (sp > XB_SPIN_CAP) { atomicAdd(&bar[XB_TMO], 1u); break; } }
    }
    nloc = mine > 0u ? mine : 1u; nx = cnt > 0u ? cnt : 1u;
}

__device__ __forceinline__ void xcd_barrier(const XcdBarrier& b) {
    asm volatile("s_waitcnt vmcnt(0)" ::: "memory");
    __syncthreads();
    if (threadIdx.x == 0) {
        unsigned* bar = b.bar;
        __builtin_amdgcn_s_waitcnt(0);
        unsigned nloc = b.st[0], nx = b.st[1];
        if (nloc == 0u) { xcd_barrier_complete(bar, b.x, nloc, nx); b.st[0] = nloc; b.st[1] = nx; }
        const unsigned old = xb_add(&bar[XB_XSUB(b.x)], 1u);
        const unsigned gen = old / nloc;
        if (old + 1u == (gen + 1u) * nloc) {
            __builtin_amdgcn_fence(__ATOMIC_RELEASE, "agent");
            asm volatile("s_waitcnt vmcnt(0)" ::: "memory");
            const unsigned og = xb_add(&bar[XB_TOP], 1u);
            const unsigned tg = og / nx;
            if (og + 1u == (tg + 1u) * nx) xb_add(&bar[XB_TOPGEN], 1u);
            else XB_SPIN(xb_ld(&bar[XB_TOPGEN]) == tg, bar);
            __builtin_amdgcn_fence(__ATOMIC_ACQUIRE, "agent");
            xb_add(&bar[XB_XGEN(b.x)], 1u);
            asm volatile("s_waitcnt vmcnt(0)" ::: "memory");
        } else {
            XB_SPIN(xb_ld(&bar[XB_XGEN(b.x)]) == gen, bar);
            __builtin_amdgcn_fence(__ATOMIC_ACQUIRE, "agent");
            asm volatile("s_waitcnt vmcnt(0)" ::: "memory");
        }
    }
    __syncthreads();
}

struct Args { const float* in[24]; float* out; unsigned char* ws; int ph_lo, ph_hi, li, pad; };
typedef const __attribute__((address_space(4))) Args* KArgs;
struct Frame { LAS unsigned char* lds; volatile LAS unsigned* MISC; gu32* ctl; int tid, lane, wave, vcu, G; unsigned char* ws; float* out; unsigned long long pr_sub; };

__device__ __forceinline__ float wave_sum(float v, int lane) {
#pragma unroll
    for (int o = 1; o < 64; o <<= 1) v += shx(v, o, lane);
    return v;
}
__device__ __forceinline__ float bf2f(unsigned short b) { return __uint_as_float((unsigned)b << 16); }
__device__ __forceinline__ float sigm(float x) { return __builtin_amdgcn_rcpf(1.0f + __expf(-x)); }

typedef float f32x2_t __attribute__((ext_vector_type(2))); typedef __bf16 bf16x2_t __attribute__((ext_vector_type(2)));
__device__ __forceinline__ unsigned cvtpk(float lo, float hi) { const f32x2_t v = {lo, hi}; const bf16x2_t b = __builtin_convertvector(v, bf16x2_t); return __builtin_bit_cast(unsigned, b); }
struct WItem { const float* W; const float* g; bf16* WT; int ldw, K, nd0, sc0, nv, k0, ldt, kofs; };
__device__ __forceinline__ void wconv_load(const WItem& t, f32x4 (&v)[16], float (&gv)[16], int lane) {
    const int c4 = (lane & 15) * 4, rk = lane >> 4; const float* gp = t.g ? t.g : t.W;
#pragma unroll
    for (int i = 0; i < 16; ++i) { const int kk = 4 * i + rk; v[i] = __builtin_nontemporal_load((const f32x4*)(t.W + (size_t)(t.k0 + kk) * t.ldw + t.sc0 + c4)); gv[i] = gp[t.k0 + kk]; }
}
__device__ __forceinline__ void wconv_store(const WItem& t, const f32x4 (&v)[16], const float (&gv)[16], LAS float* scr, int lane) {
    const int c4 = (lane & 15) * 4, rk = lane >> 4; const float vm = (c4 < t.nv) ? 1.0f : 0.0f;
#pragma unroll
    for (int i = 0; i < 16; ++i) { const float gg = t.g ? gv[i] * vm : vm; LAS float* d = scr + (4 * i + rk) * 65 + c4; d[0] = v[i][0] * gg; d[1] = v[i][1] * gg; d[2] = v[i][2] * gg; d[3] = v[i][3] * gg; }
    LDS_WAIT(); asm volatile("" ::: "memory");
    const int c = lane & 7;
#pragma unroll
    for (int jj = 0; jj < 8; ++jj) { const int n = (lane >> 3) + 8 * jj; const LAS float* s = scr + (8 * c) * 65 + n;
        v4u o; o.x = cvtpk(s[0 * 65], s[1 * 65]); o.y = cvtpk(s[2 * 65], s[3 * 65]); o.z = cvtpk(s[4 * 65], s[5 * 65]); o.w = cvtpk(s[6 * 65], s[7 * 65]);
        *(GAS v4u*)(t.WT + (size_t)(t.nd0 + n) * t.ldt + t.kofs + t.k0 + 8 * c) = o; }
    LDS_WAIT(); asm volatile("" ::: "memory");
}
__device__ __forceinline__ WItem wconv_decode(Frame& F, KArgs a, int l, int it) {
    constexpr int I_IN = 16 * 88, I_GU = 16 * 88, I_ATT = 8 * 16, I_SSD = 16 * 16, I_OUT = 16 * 16;
    int r = it; WItem t; t.g = nullptr; t.nv = 64; t.kofs = 0;
    if (r < I_IN) { const int nd0 = (r % 88) * 64; t.k0 = (r / 88) * 64; t.nd0 = nd0; t.sc0 = 0;
        if (nd0 < 3328) t.sc0 = nd0; else if (nd0 < 5376) t.sc0 = nd0 + 16; else if (nd0 == 5376) { t.sc0 = 3328; t.nv = 16; } else t.nv = 0;
        t.W = a->in[8] + (size_t)l * 1024 * 5392; t.ldw = 5392; t.K = 1024; t.WT = (bf16*)(F.ws + WS_WIN); t.g = a->in[7] + l * 1024; }
    else if ((r -= I_IN) < I_GU) { const int nd0 = (r % 88) * 64, tt = nd0 >> 8, jj = nd0 & 255; t.k0 = (r / 88) * 64; t.nd0 = nd0; t.sc0 = 128 * tt + (jj & 127);
        t.W = (jj < 128 ? a->in[20] : a->in[21]) + (size_t)l * 1024 * 2816; t.ldw = 2816; t.K = 1024; t.WT = (bf16*)(F.ws + WS_WGU); t.g = a->in[19] + l * 1024; }
    else if ((r -= I_GU) < I_ATT) { t.k0 = (r / 16) * 64; t.nd0 = t.sc0 = (r % 16) * 64; t.W = a->in[16] + (size_t)l * 512 * 1024; t.ldw = 1024; t.K = 512; t.WT = (bf16*)(F.ws + WS_WATT); t.ldt = 1536; return t; }
    else if ((r -= I_ATT) < I_SSD) { t.k0 = (r / 16) * 64; t.nd0 = t.sc0 = (r % 16) * 64; t.W = a->in[17] + (size_t)l * 1024 * 1024; t.ldw = 1024; t.K = 1024; t.WT = (bf16*)(F.ws + WS_WATT); t.ldt = 1536; t.kofs = 512; t.g = a->in[14] + l * 1024; return t; }
    else if ((r -= I_SSD) < I_OUT) { t.k0 = (r / 16) * 64; t.nd0 = t.sc0 = (r % 16) * 64; t.W = a->in[18] + (size_t)l * 1024 * 1024; t.ldw = 1024; t.K = 1024; t.WT = (bf16*)(F.ws + WS_WOUT); }
    else { r -= I_OUT; t.k0 = (r / 16) * 64; t.nd0 = t.sc0 = (r % 16) * 64; t.W = a->in[22] + (size_t)l * 2816 * 1024; t.ldw = 1024; t.K = 2816; t.WT = (bf16*)(F.ws + WS_WDN); }
    t.ldt = t.K; return t;
}
__device__ __forceinline__ void p0_convert(Frame& F, KArgs a, int l) {
    LAS float* scr = (LAS float*)(F.lds + F.wave * 16896);
    const int gw = F.vcu * NWAVES + F.wave, NGW = F.G * NWAVES;
    constexpr int NITEMS = MK_SPLIT ? 16 * 88 * 2 + 8 * 16 + 16 * 16 * 2 + 44 * 16 : 16 * 88;
    {
        f32x4 va[16], vb[16]; float ga[16], gb[16];
        int it = gw; WItem ta, tb_;
        if (it < NITEMS) { ta = wconv_decode(F, a, l, it); wconv_load(ta, va, ga, F.lane); }
        while (it < NITEMS) {
            const int it2 = it + NGW, it3 = it2 + NGW;
            if (it2 < NITEMS) { tb_ = wconv_decode(F, a, l, it2); wconv_load(tb_, vb, gb, F.lane); }
            wconv_store(ta, va, ga, scr, F.lane);
            if (it2 >= NITEMS) break;
            if (it3 < NITEMS) { ta = wconv_decode(F, a, l, it3); wconv_load(ta, va, ga, F.lane); }
            wconv_store(tb_, vb, gb, scr, F.lane);
            it = it3;
        }
    }
    if (l == 0) {
        bf16* XB = (bf16*)(F.ws + WS_XB); float* SSQX = (float*)(F.ws + WS_SSQX);
        for (int m0 = 2 * gw; m0 < MALL; m0 += 2 * NGW) {
            f32x4 v[2][4];
#pragma unroll
            for (int q = 0; q < 2; ++q) { const int m = m0 + q; const float* xrow = m < MP ? a->in[0] + (size_t)m * DM : a->in[1] + (size_t)(m - MP) * DM;
                const GAS f32x4* xr = (const GAS f32x4*)xrow + F.lane;
#pragma unroll
                for (int j = 0; j < 4; ++j) v[q][j] = __builtin_nontemporal_load((const f32x4*)(xrow) + F.lane + 64 * j); }
#pragma unroll
            for (int q = 0; q < 2; ++q) { const int m = m0 + q; float s = 0.f;
#pragma unroll
                for (int j = 0; j < 4; ++j) s += (v[q][j].x * v[q][j].x + v[q][j].y * v[q][j].y) + (v[q][j].z * v[q][j].z + v[q][j].w * v[q][j].w);
                s = wave_sum(s, F.lane);
                GAS unsigned long long* o8 = (GAS unsigned long long*)(XB + (size_t)m * DM) + F.lane;
#pragma unroll
                for (int j = 0; j < 4; ++j) o8[64 * j] = (unsigned long long)cvtpk(v[q][j].x, v[q][j].y) | ((unsigned long long)cvtpk(v[q][j].z, v[q][j].w) << 32);
                if (F.lane < 16) SSQX[(size_t)m * 16 + F.lane] = F.lane == 0 ? s : 0.f; }
        }
    }
}

template <int SUB>
__device__ __forceinline__ void p0_convert_slack(Frame& F, KArgs a, int l) {
    if ((int)blockIdx.x < 150) return;
    LAS float* scr = (LAS float*)(F.lds + F.wave * 16896);
    const int gw = ((int)blockIdx.x - 150) * NWAVES + F.wave, NGW = 106 * NWAVES;
    constexpr int I_IN = 16 * 88, I_GU = 16 * 88, I_ATT = 8 * 16, I_SSD = 16 * 16, I_OUT = 16 * 16, I_DN = 44 * 16;
    constexpr int NSUB = SUB == 0 ? I_IN + I_ATT + I_SSD + I_OUT : (SUB == 1 ? I_GU + I_DN : I_GU + I_ATT + I_SSD + I_OUT + I_DN);
#define P0S_MAP(s) (SUB == 0 ? ((s) < I_IN ? (s) : (s) + I_GU) : (SUB == 1 ? ((s) < I_GU ? (s) + I_IN : (s) + I_IN + I_ATT + I_SSD + I_OUT) : (s) + I_IN))
    f32x4 va[16], vb[16]; float ga[16], gb[16];
    int it = gw; WItem ta, tb_;
    if (it < NSUB) { ta = wconv_decode(F, a, l, P0S_MAP(it)); wconv_load(ta, va, ga, F.lane); }
    while (it < NSUB) {
        const int it2 = it + NGW, it3 = it2 + NGW;
        if (it2 < NSUB) { tb_ = wconv_decode(F, a, l, P0S_MAP(it2)); wconv_load(tb_, vb, gb, F.lane); }
        wconv_store(ta, va, ga, scr, F.lane);
        if (it2 >= NSUB) break;
        if (it3 < NSUB) { ta = wconv_decode(F, a, l, P0S_MAP(it3)); wconv_load(ta, va, ga, F.lane); }
        wconv_store(tb_, vb, gb, scr, F.lane);
        it = it3;
    }
#undef P0S_MAP
}

typedef LAS unsigned short lbf;
typedef short v4i16_t __attribute__((ext_vector_type(4)));
__device__ __forceinline__ bf16x8 ldfrag(const lbf* base, int row, int ld, int k0, int lane) { return *(const LAS bf16x8*)(base + row * ld + k0 + 8 * (lane >> 4)); }
__device__ __forceinline__ bf16x8 ldfrag_tr(const lbf* M, int ld, int k0, int c0, int lane) {
    const int i16 = lane & 15;
    const lbf* p0 = M + (k0 + 8 * (lane >> 4) + (i16 >> 2)) * ld + c0 + 4 * (i16 & 3);
    const v4i16_t lo = __builtin_amdgcn_ds_read_tr16_b64_v4i16((LAS v4i16_t*)p0);
    const v4i16_t hi = __builtin_amdgcn_ds_read_tr16_b64_v4i16((LAS v4i16_t*)(p0 + 4 * ld));
    return (bf16x8){lo[0], lo[1], lo[2], lo[3], hi[0], hi[1], hi[2], hi[3]};
}
#define WG_BAR() do { asm volatile("s_waitcnt lgkmcnt(0)" ::: "memory"); __builtin_amdgcn_s_barrier(); asm volatile("" ::: "memory"); } while (0)
template <int CTRL> __device__ __forceinline__ float dppf(float v) { return __int_as_float(__builtin_amdgcn_update_dpp(0, __float_as_int(v), CTRL, 0xf, 0xf, true)); }
__device__ __forceinline__ float row16_sum(float s) { s += dppf<0xB1>(s); s += dppf<0x4E>(s); s += dppf<0x141>(s); s += dppf<0x140>(s); return s; }
#define MFMA16(a, b, c) __builtin_amdgcn_mfma_f32_16x16x32_bf16((a), (b), (c), 0, 0, 0)
#define FRAME_REOPAQUE(F) do { int tv_ = threadIdx.x; asm volatile("" : "+v"(tv_)); (F).tid = tv_; (F).lane = tv_ & 63; (F).wave = __builtin_amdgcn_readfirstlane(tv_ >> 6); } while (0)
__device__ __forceinline__ int t5_bucket(int rel) {
    const int n = rel < 0 ? -rel : rel;
    const int big = 8 + (n >= 12) + (n >= 16) + (n >= 23) + (n >= 32) + (n >= 46) + (n >= 64) + (n >= 91);
    return (rel > 0 ? 16 : 0) + (n < 8 ? n : big);
}
__device__ __forceinline__ void unpk8(const v4u w, float (&d)[8]) {
    d[0] = __uint_as_float(w.x << 16); d[1] = __uint_as_float(w.x & 0xffff0000u); d[2] = __uint_as_float(w.y << 16); d[3] = __uint_as_float(w.y & 0xffff0000u);
    d[4] = __uint_as_float(w.z << 16); d[5] = __uint_as_float(w.z & 0xffff0000u); d[6] = __uint_as_float(w.w << 16); d[7] = __uint_as_float(w.w & 0xffff0000u);
}
constexpr int AT_KS = 0, AT_KLD = 72, AT_V = 27648, AT_VLD = 80, AT_P = 58368, AT_PLD = 200, AT_TB = 109568;
__device__ __forceinline__ void attn_tables(Frame& F, KArgs a) {
    LAS float* tb = (LAS float*)(F.lds + AT_TB);
    for (int e = F.tid; e < 2048; e += 512) { const int gg = e >> 10, r = (e >> 8) & 3, rel = (e & 255) - 192; tb[e] = a->in[6][t5_bucket(rel) * 8 + gg * 4 + r] * 1.4426950408889634f; }
    __syncthreads();
}
template <bool SAMPLE>
__device__ __forceinline__ void attn_unit(Frame& F, KArgs a, int l, int b, int c, int g) {
    lbf* Ks = (lbf*)(F.lds + AT_KS); lbf* Vs = (lbf*)(F.lds + AT_V); lbf* Pw = (lbf*)(F.lds + AT_P) + F.wave * (16 * AT_PLD); const LAS float* tb = (const LAS float*)(F.lds + AT_TB) + g * 1024;
    bf16* Qb = (bf16*)(F.ws + WS_Q); const bf16* KVb = (const bf16*)(F.ws + WS_KV);
    const int tid = F.tid, lane = F.lane, wave = F.wave;
    const int rowbase = SAMPLE ? MP + b * 16 : b * 4096 + c * 64;
    const int npass = SAMPLE ? (wave < 4 ? 1 : 0) : 2;
    const int r = SAMPLE ? (wave & 3) : (wave >> 1);
    const int q4 = lane >> 4, fr = lane & 15;
    bf16x8 qfa[2][2];
#pragma unroll
    for (int ps = 0; ps < 2; ++ps) { const int i0 = SAMPLE ? 0 : (wave & 1) * 32 + ps * 16; const size_t qoff = (size_t)(rowbase + i0 + fr) * OY_LD + (g * 4 + r) * 64;
        qfa[ps][0] = *(const bf16x8*)(Qb + qoff + 8 * q4); qfa[ps][1] = *(const bf16x8*)(Qb + qoff + 32 + 8 * q4); }
    for (int e = tid; e < 1536; e += 512) {
        const int key = e >> 3, pc = e & 7;
        v4u kp = (v4u){0u, 0u, 0u, 0u}, vp = (v4u){0u, 0u, 0u, 0u}; float kf[8], vf[8]; bool valid, exact = false;
        if (SAMPLE) {
            valid = key < 144;
            if (key < 128) { exact = true;
                const size_t off = (((size_t)(l * 16 + b) * 128 + key) * 2 + g) * 64 + pc * 8;
                const f32x4 k0 = *(const f32x4*)(a->in[2] + off), k1 = *(const f32x4*)(a->in[2] + off + 4), v0 = *(const f32x4*)(a->in[3] + off), v1 = *(const f32x4*)(a->in[3] + off + 4);
#pragma unroll
                for (int j = 0; j < 4; ++j) { kf[j] = k0[j]; kf[4 + j] = k1[j]; vf[j] = v0[j]; vf[4 + j] = v1[j]; }
                kp.x = cvtpk(kf[0], kf[1]); kp.y = cvtpk(kf[2], kf[3]); kp.z = cvtpk(kf[4], kf[5]); kp.w = cvtpk(kf[6], kf[7]);
                vp.x = cvtpk(vf[0], vf[1]); vp.y = cvtpk(vf[2], vf[3]); vp.z = cvtpk(vf[4], vf[5]); vp.w = cvtpk(vf[6], vf[7]);
            }
        } else valid = (c - 2) * 64 + key >= 0;
        if (SAMPLE) { if (valid && !exact) { const size_t row = (size_t)(MP + b * 16 + key - 128);
                kp = *(const v4u*)(KVb + row * 256 + g * 64 + pc * 8); vp = *(const v4u*)(KVb + row * 256 + 128 + g * 64 + pc * 8); } }
        else { const int pos = (c - 2) * 64 + key; const size_t row = (size_t)(b * 4096 + (pos < 0 ? 0 : pos)); const unsigned k_ = valid ? 0xffffffffu : 0u;
            const v4u k0_ = *(const v4u*)(KVb + row * 256 + g * 64 + pc * 8), v0_ = *(const v4u*)(KVb + row * 256 + 128 + g * 64 + pc * 8);
            kp = (v4u){k0_.x & k_, k0_.y & k_, k0_.z & k_, k0_.w & k_}; vp = (v4u){v0_.x & k_, v0_.y & k_, v0_.z & k_, v0_.w & k_}; }
        *(LAS v4u*)(Ks + key * AT_KLD + pc * 8) = kp; *(LAS v4u*)(Vs + key * AT_VLD + pc * 8) = vp;
        float* ko = nullptr; float* vo = nullptr;
        if (SAMPLE) { if (key >= 16 && key < 144) { const size_t o = (((size_t)(l * 16 + b) * 128 + key - 16) * 2 + g) * 64 + pc * 8; ko = F.out + O_KS + o; vo = F.out + O_VS + o; } }
        else if (c >= 62 && key >= 128) { const size_t o = (((size_t)(l * 4 + b) * 128 + (c - 62) * 64 + key - 128) * 2 + g) * 64 + pc * 8; ko = F.out + O_KP + o; vo = F.out + O_VP + o; }
        if (ko) { if (!exact) { unpk8(kp, kf); unpk8(vp, vf); }
                  *(f32x4*)ko = (f32x4){kf[0], kf[1], kf[2], kf[3]}; *(f32x4*)(ko + 4) = (f32x4){kf[4], kf[5], kf[6], kf[7]};
                  *(f32x4*)vo = (f32x4){vf[0], vf[1], vf[2], vf[3]}; *(f32x4*)(vo + 4) = (f32x4){vf[4], vf[5], vf[6], vf[7]}; }
    }
    WG_BAR();
    const float sink = a->in[15][l * 8 + g * 4 + r] * 1.4426950408889634f;
#pragma unroll
    for (int ps = 0; ps < 2; ++ps) { if (ps >= npass) break;
        const int i0 = SAMPLE ? 0 : (wave & 1) * 32 + ps * 16;
        const bf16x8 qf0 = qfa[ps][0], qf1 = qfa[ps][1];
        f32x4 s[12];
#pragma unroll
        for (int hf = 0; hf < 2; ++hf) {
            bf16x8 kfr[6][2];
#pragma unroll
            for (int kk = 0; kk < 6; ++kk) { kfr[kk][0] = ldfrag(Ks, 16 * (6 * hf + kk) + fr, AT_KLD, 0, lane); kfr[kk][1] = ldfrag(Ks, 16 * (6 * hf + kk) + fr, AT_KLD, 32, lane); }
            asm volatile("" ::: "memory");
#pragma unroll
            for (int kk = 0; kk < 6; ++kk) { const int kt = 6 * hf + kk; s[kt] = (f32x4){0.f, 0.f, 0.f, 0.f};
                s[kt] = MFMA16(kfr[kk][0], qf0, s[kt]); s[kt] = MFMA16(kfr[kk][1], qf1, s[kt]); }
        }
        const int jlo = SAMPLE ? 0 : (c >= 2 ? 0 : (2 - c) * 64), jhi = SAMPLE ? 144 : 192;
        float mx = -3.0e38f; float bz[12][4];
#pragma unroll
        for (int kt = 0; kt < 12; ++kt)
#pragma unroll
            for (int ii = 0; ii < 4; ++ii) bz[kt][ii] = tb[r * 256 + 16 * kt + 4 * q4 + ii - (i0 + fr) + 64];
        asm volatile("" ::: "memory");
#pragma unroll
        for (int kt = 0; kt < 12; ++kt)
#pragma unroll
            for (int ii = 0; ii < 4; ++ii) s[kt][ii] = s[kt][ii] * 0.18033688011112042f + bz[kt][ii];
        if (SAMPLE || jlo > 0) {
#pragma unroll
            for (int kt = 0; kt < 12; ++kt)
#pragma unroll
                for (int ii = 0; ii < 4; ++ii) { const int key = 16 * kt + 4 * q4 + ii; s[kt][ii] = (key >= jlo && key < jhi) ? s[kt][ii] : -1.0e30f; }
        }
#pragma unroll
        for (int kt = 0; kt < 12; ++kt) mx = fmaxf(mx, fmaxf(fmaxf(s[kt][0], s[kt][1]), fmaxf(s[kt][2], s[kt][3])));
        mx = fmaxf(mx, shx(mx, 16, lane)); mx = fmaxf(mx, shx(mx, 32, lane)); mx = fmaxf(mx, sink);
        float sum = 0.f;
#pragma unroll
        for (int kt = 0; kt < 12; ++kt)
#pragma unroll
            for (int ii = 0; ii < 4; ++ii) { const float p = __builtin_amdgcn_exp2f(s[kt][ii] - mx); s[kt][ii] = p; sum += p; }
        sum += shx(sum, 16, lane); sum += shx(sum, 32, lane);
        const float inv = 1.0f / (sum + __builtin_amdgcn_exp2f(sink - mx));
#pragma unroll
        for (int kt = 0; kt < 12; ++kt) {
            const unsigned long long w = (unsigned long long)cvtpk(s[kt][0], s[kt][1]) | ((unsigned long long)cvtpk(s[kt][2], s[kt][3]) << 32);
            *(LAS unsigned long long*)(Pw + fr * AT_PLD + 16 * kt + 4 * q4) = w; }
        LDS_WAIT(); asm volatile("" ::: "memory");
        f32x4 o[4];
#pragma unroll
        for (int dt = 0; dt < 4; ++dt) o[dt] = (f32x4){0.f, 0.f, 0.f, 0.f};
#pragma unroll
        for (int k2 = 0; k2 < 3; ++k2) {
            bf16x8 pa[2], vf[2][4];
#pragma unroll
            for (int kq = 0; kq < 2; ++kq) { pa[kq] = ldfrag(Pw, fr, AT_PLD, (2 * k2 + kq) * 32, lane);
#pragma unroll
                for (int dt = 0; dt < 4; ++dt) vf[kq][dt] = ldfrag_tr(Vs, AT_VLD, (2 * k2 + kq) * 32, 16 * dt, lane); }
            asm volatile("" ::: "memory");
#pragma unroll
            for (int kq = 0; kq < 2; ++kq)
#pragma unroll
                for (int dt = 0; dt < 4; ++dt) o[dt] = MFMA16(pa[kq], vf[kq][dt], o[dt]);
        }
        asm volatile("" ::: "memory");
        { float iq[4];
#pragma unroll
          for (int ii = 0; ii < 4; ++ii) iq[ii] = bperm_f(inv, 4 * q4 + ii);
#pragma unroll
          for (int dt = 0; dt < 4; ++dt)
#pragma unroll
            for (int ii = 0; ii < 4; ++ii) Pw[(4 * q4 + ii) * AT_KLD + 16 * dt + fr] = (unsigned short)(cvtpk(o[dt][ii] * iq[ii], 0.f) & 0xffffu); }
        LDS_WAIT(); asm volatile("" ::: "memory");
        { const int orow = lane >> 2, och = (lane & 3) * 16;
          const v4u w0 = *(const LAS v4u*)(Pw + orow * AT_KLD + och), w1 = *(const LAS v4u*)(Pw + orow * AT_KLD + och + 8);
          bf16* op = Qb + (size_t)(rowbase + i0 + orow) * OY_LD + (g * 4 + r) * 64 + och;
          *(v4u*)op = w0; *(v4u*)(op + 8) = w1; }
        LDS_WAIT(); asm volatile("" ::: "memory");
    }
    WG_BAR();
}

constexpr int S2_CM = 0, S2_BM = 17408, S2_X = 34816, S2_XS = 55296, S2_GM = 75776, S2_HB = 94208, S2_SC = 129024;
constexpr int S2_LDN = 136, S2_LDX = 80, S2_LDG = 72, S2_XH = 64 * 80, S2_GH = 64 * 72, S2_HH = 64 * 136;
constexpr int NSEG = 8, SEGCH = 8;
__device__ __forceinline__ void unpk4(unsigned long long w, float (&d)[4]) {
    d[0] = __uint_as_float((unsigned)w << 16); d[1] = __uint_as_float((unsigned)w & 0xffff0000u); d[2] = __uint_as_float((unsigned)(w >> 32) << 16); d[3] = __uint_as_float((unsigned)(w >> 32) & 0xffff0000u);
}
template <int MODE>
__device__ __forceinline__ void ssd_unit(Frame& F, KArgs a, int l, int b, int hp, int seg) {
    constexpr bool SAMPLE = MODE == 2, FULL = MODE != 1;
    lbf* Cm = (lbf*)(F.lds + S2_CM); lbf* Bm = (lbf*)(F.lds + S2_BM); lbf* Xm = (lbf*)(F.lds + S2_X); lbf* Xs = (lbf*)(F.lds + S2_XS);
    lbf* Gm = (lbf*)(F.lds + S2_GM); lbf* Hb = (lbf*)(F.lds + S2_HB); LAS float* scb = (LAS float*)(F.lds + S2_SC);
    const int tid = F.tid, lane = F.lane, wave = F.wave, q4 = lane >> 4, fr = lane & 15, g = hp >> 2, hh = wave >> 2, w4 = wave & 3, h = 2 * hp + hh;
    const bf16* XBC = (const bf16*)(F.ws + WS_XBC); bf16* Zb = (bf16*)(F.ws + WS_Q) + OY_Z;     const float* DT = (const float*)(F.ws + WS_DT); float* SSQY = (float*)(F.ws + WS_SSQY);
    float* SEGE = F.out; float* SEGD = (float*)(F.ws + WS_SEGD);
    const float a_h = -__expf(a->in[12][l * 16 + h]);
    const int L = SAMPLE ? 16 : 64, nchunk = SAMPLE ? 1 : SEGCH, c0 = SAMPLE ? 0 : seg * SEGCH;
    const int uh = (b * 16 + h) * (NSEG - 1);
    f32x4 hacc[8];
#pragma unroll
    for (int j = 0; j < 8; ++j) {
#pragma unroll
        for (int i = 0; i < 4; ++i) hacc[j][i] = SAMPLE ? a->in[5][(((size_t)(l * 16 + b) * 16 + h) * 64 + 16 * w4 + fr) * 128 + 16 * j + 4 * q4 + i] : 0.f;
    }
    constexpr int NPR = FULL ? 48 : 32, NPC = FULL ? 6 : 4;
    const bf16* CX = (const bf16*)((const unsigned char*)F.out + OUT_CX_BYTES);
    v4u tp[NPC];
#define SSD_PREFETCH(r0_) do { _Pragma("unroll") for (int i = 0; i < NPC; ++i) { const int q_ = tid + 512 * i, row_ = q_ / NPR, pc_ = q_ % NPR; \
        const int col_ = pc_ < 16 ? (2 * hp) * 64 + pc_ * 8 : (pc_ < 32 ? 1024 + g * 128 + (pc_ - 16) * 8 : 1280 + g * 128 + (pc_ - 32) * 8); \
        tp[i] = *(const v4u*)(CX + (size_t)((r0_) + (SAMPLE ? (row_ & 15) : row_)) * 1536 + col_); } } while (0)
    float dtv = 0.f;
    if (SAMPLE) { SSD_PREFETCH(MP + b * 16); if (w4 == 0) { const float d_ = DT[(size_t)(MP + b * 16 + (lane & 15)) * 16 + h]; dtv = lane < 16 ? d_ : 0.f; } }
    else { SSD_PREFETCH(b * 4096 + c0 * 64); if (w4 == 0) dtv = DT[(size_t)(b * 4096 + c0 * 64 + lane) * 16 + h]; }
    if (MODE == 0) {
        const unsigned long long* Eb = (const unsigned long long*)SEGE + (size_t)uh * 2048 + (w4 * 8) * 64 + lane;
        unsigned long long ea[8], eb[8];
        if (seg > 0) {
#pragma unroll
            for (int j = 0; j < 8; ++j) ea[j] = Eb[j * 64];
        }
        for (int s2 = 0; s2 < seg; s2 += 2) {
            const bool two = s2 + 1 < seg;
            if (two) {
#pragma unroll
                for (int j = 0; j < 8; ++j) eb[j] = Eb[(s2 + 1) * 2048 + j * 64];
            }
            { const float dec = __expf(SEGD[uh + s2]);
#pragma unroll
              for (int j = 0; j < 8; ++j) { float e4[4]; unpk4(ea[j], e4); hacc[j] = hacc[j] * dec + (f32x4){e4[0], e4[1], e4[2], e4[3]}; } }
            if (s2 + 2 < seg) {
#pragma unroll
                for (int j = 0; j < 8; ++j) ea[j] = Eb[(s2 + 2) * 2048 + j * 64];
            }
            if (two) { const float dec = __expf(SEGD[uh + s2 + 1]);
#pragma unroll
              for (int j = 0; j < 8; ++j) { float e4[4]; unpk4(eb[j], e4); hacc[j] = hacc[j] * dec + (f32x4){e4[0], e4[1], e4[2], e4[3]}; } }
        }
    }
#define SSD_MIRROR() do { _Pragma("unroll") for (int j = 0; j < 8; ++j) \
        *(LAS unsigned long long*)(Hb + hh * S2_HH + (16 * w4 + fr) * S2_LDN + 16 * j + 4 * q4) = (unsigned long long)cvtpk(hacc[j][0], hacc[j][1]) | ((unsigned long long)cvtpk(hacc[j][2], hacc[j][3]) << 32); } while (0)
    if (FULL) SSD_MIRROR();
    float segsum = 0.f;
    const float D0 = a->in[13][l * 16 + 2 * hp], D1 = a->in[13][l * 16 + 2 * hp + 1];
#define SSD_SCAN(buf) do { float ac = dtv * a_h; _Pragma("unroll") for (int o = 1; o < 64; o <<= 1) { const float t = bperm_f(ac, lane >= o ? lane - o : lane); if (lane >= o) ac += t; } \
        const float tot = bperm_f(ac, 63); segsum += tot; LAS float* sc__ = scb + (hh * 2 + (buf)) * 192; sc__[lane] = dtv; sc__[64 + lane] = ac; sc__[128 + lane] = dtv * __expf(tot - ac); } while (0)
    if (w4 == 0) SSD_SCAN(0);
    WG_BAR();
    for (int cc = 0; cc < nchunk; ++cc) {
        const int c = c0 + cc, cur = cc & 1;
        const int r0 = SAMPLE ? MP + b * 16 : b * 4096 + c * 64;
        const LAS float* sc0 = scb + cur * 192; const LAS float* sc1 = scb + (2 + cur) * 192; const LAS float* scm = hh ? sc1 : sc0;
        unsigned short zv[4][4];
#pragma unroll
        for (int pt = 0; pt < 4; ++pt)
#pragma unroll
            for (int i = 0; i < 4; ++i) { const int lidx = 16 * w4 + 4 * q4 + i; zv[pt][i] = Zb[(size_t)(r0 + (SAMPLE ? (lidx & 15) : lidx)) * OY_LD + h * 64 + 16 * pt + fr]; }
        if (FULL && cc > 0) SSD_MIRROR();
#pragma unroll
        for (int i = 0; i < NPC; ++i) { const int q_ = tid + 512 * i, row_ = q_ / NPR, pc_ = q_ % NPR;
            if (SAMPLE && row_ >= 16) tp[i] = (v4u){0u, 0u, 0u, 0u};
            if (pc_ < 16) { const int hc = pc_ >> 3, p0 = (pc_ & 7) * 8; const float wl = (hc ? sc1 : sc0)[128 + row_];
                if (FULL) *(LAS v4u*)(Xm + hc * S2_XH + row_ * S2_LDX + p0) = tp[i];
                float xv[8]; unpk8(tp[i], xv); v4u sx; sx.x = cvtpk(xv[0] * wl, xv[1] * wl); sx.y = cvtpk(xv[2] * wl, xv[3] * wl); sx.z = cvtpk(xv[4] * wl, xv[5] * wl); sx.w = cvtpk(xv[6] * wl, xv[7] * wl);
                *(LAS v4u*)(Xs + hc * S2_XH + row_ * S2_LDX + p0) = sx; }
            else if (pc_ < 32) *(LAS v4u*)(Bm + row_ * S2_LDN + (pc_ - 16) * 8) = tp[i];
            else *(LAS v4u*)(Cm + row_ * S2_LDN + (pc_ - 32) * 8) = tp[i]; }
        if (!SAMPLE && cc + 1 < nchunk) { SSD_PREFETCH(b * 4096 + (c + 1) * 64); if (w4 == 0) dtv = DT[(size_t)(b * 4096 + (c + 1) * 64 + lane) * 16 + h]; }
        WG_BAR();
        { const float dec = __expf(scm[64 + 63]);
          const bf16x8 xa0 = ldfrag_tr(Xs + hh * S2_XH, S2_LDX, 0, 16 * w4, lane), xa1 = ldfrag_tr(Xs + hh * S2_XH, S2_LDX, 32, 16 * w4, lane);
#pragma unroll
          for (int jh = 0; jh < 2; ++jh) { bf16x8 bb[4][2];
#pragma unroll
              for (int j4 = 0; j4 < 4; ++j4) { bb[j4][0] = ldfrag_tr(Bm, S2_LDN, 0, 16 * (4 * jh + j4), lane); bb[j4][1] = ldfrag_tr(Bm, S2_LDN, 32, 16 * (4 * jh + j4), lane); }
              asm volatile("" ::: "memory");
#pragma unroll
              for (int j4 = 0; j4 < 4; ++j4) { const int j = 4 * jh + j4; hacc[j] = hacc[j] * dec; hacc[j] = MFMA16(bb[j4][0], xa0, hacc[j]); hacc[j] = MFMA16(bb[j4][1], xa1, hacc[j]); } }
        }
        if (!FULL) { if (w4 == 0 && cc + 1 < nchunk) SSD_SCAN(cur ^ 1); WG_BAR(); continue; }
        { bf16x8 ac4[4];
#pragma unroll
          for (int ks = 0; ks < 4; ++ks) ac4[ks] = ldfrag(Cm, 16 * w4 + fr, S2_LDN, 32 * ks, lane);
          lbf* Gw = Gm + hh * S2_GH + (16 * w4) * S2_LDG;
          const float Dd = hh ? D1 : D0; const int lidx = 16 * w4 + fr; const float ac_l = scm[64 + lidx];
#pragma unroll
          for (int st = 0; st < 4; ++st) {
              unsigned long long gp = 0ull;
              if (st <= w4) { bf16x8 fb[4];
#pragma unroll
                  for (int ks = 0; ks < 4; ++ks) fb[ks] = ldfrag(Bm, 16 * st + fr, S2_LDN, 32 * ks, lane);
                  asm volatile("" ::: "memory");
                  f32x4 acc = (f32x4){0.f, 0.f, 0.f, 0.f};
#pragma unroll
                  for (int ks = 0; ks < 4; ++ks) acc = MFMA16(fb[ks], ac4[ks], acc);
                  const int s0 = 16 * st + 4 * q4; const f32x4 ac_s = *(const LAS f32x4*)(scm + 64 + s0), dt_s = *(const LAS f32x4*)(scm + s0);
                  float gv[4];
#pragma unroll
                  for (int i = 0; i < 4; ++i) { gv[i] = (s0 + i <= lidx) ? acc[i] * __expf(ac_l - ac_s[i]) * dt_s[i] : 0.f; gv[i] += (s0 + i == lidx) ? Dd : 0.f; }
                  gp = (unsigned long long)cvtpk(gv[0], gv[1]) | ((unsigned long long)cvtpk(gv[2], gv[3]) << 32); }
              *(LAS unsigned long long*)(Gw + fr * S2_LDG + 16 * st + 4 * q4) = gp;
          }
          LDS_WAIT(); asm volatile("" ::: "memory");
          const bf16x8 ag0 = ldfrag(Gw, fr, S2_LDG, 0, lane), ag1 = ldfrag(Gw, fr, S2_LDG, 32, lane);
          float eac[4], sq[4];
#pragma unroll
          for (int i = 0; i < 4; ++i) { eac[i] = __expf(scm[64 + 16 * w4 + 4 * q4 + i]); sq[i] = 0.f; }
          lbf* Ys = Gm + hh * S2_GH + (16 * w4) * S2_LDG;
          f32x4 yv[4];
#pragma unroll
          for (int pt = 0; pt < 4; ++pt) {
              bf16x8 xq[2], hq[4];
              xq[0] = ldfrag_tr(Xm + hh * S2_XH, S2_LDX, 0, 16 * pt, lane); xq[1] = ldfrag_tr(Xm + hh * S2_XH, S2_LDX, 32, 16 * pt, lane);
#pragma unroll
              for (int ks = 0; ks < 4; ++ks) hq[ks] = ldfrag(Hb + hh * S2_HH, 16 * pt + fr, S2_LDN, 32 * ks, lane);
              asm volatile("" ::: "memory");
              f32x4 yd = (f32x4){0.f, 0.f, 0.f, 0.f}, yo = (f32x4){0.f, 0.f, 0.f, 0.f};
              yd = MFMA16(ag0, xq[0], yd); yd = MFMA16(ag1, xq[1], yd);
#pragma unroll
              for (int ks = 0; ks < 4; ++ks) yo = MFMA16(ac4[ks], hq[ks], yo);
#pragma unroll
              for (int i = 0; i < 4; ++i) { const float z = bf2f(zv[pt][i]); const float y = (yd[i] + eac[i] * yo[i]) * (z * sigm(z)); yv[pt][i] = y; sq[i] += y * y; }
          }
          asm volatile("" ::: "memory");
#pragma unroll
          for (int pt = 0; pt < 4; ++pt)
#pragma unroll
              for (int i = 0; i < 4; ++i) Ys[(4 * q4 + i) * S2_LDG + 16 * pt + fr] = (unsigned short)(cvtpk(yv[pt][i], 0.f) & 0xffffu);
#pragma unroll
          for (int i = 0; i < 4; ++i) { const float s = row16_sum(sq[i]);
              const int lidx = 16 * w4 + 4 * q4 + i; if (fr == 0 && lidx < L) SSQY[(size_t)(r0 + lidx) * 16 + h] = s; }
          LDS_WAIT(); asm volatile("" ::: "memory");
          { const int orow = lane >> 2, och = (lane & 3) * 16;
            const v4u y0 = *(const LAS v4u*)(Ys + orow * S2_LDG + och), y1 = *(const LAS v4u*)(Ys + orow * S2_LDG + och + 8);
            if (16 * w4 + orow < L) { bf16* yp = Zb + (size_t)(r0 + 16 * w4 + orow) * OY_LD + h * 64 + och; *(v4u*)yp = y0; *(v4u*)(yp + 8) = y1; } }
        }
        if (w4 == 0 && cc + 1 < nchunk) SSD_SCAN(cur ^ 1);
        WG_BAR();
    }
#undef SSD_PREFETCH
#undef SSD_SCAN
#undef SSD_MIRROR
    if (MODE == 1) {
#pragma unroll
        for (int j = 0; j < 8; ++j) ((unsigned long long*)SEGE)[(size_t)(uh + seg) * 2048 + (w4 * 8 + j) * 64 + lane] = (unsigned long long)cvtpk(hacc[j][0], hacc[j][1]) | ((unsigned long long)cvtpk(hacc[j][2], hacc[j][3]) << 32);
        if (w4 == 0 && lane == 0) SEGD[uh + seg] = segsum;
    } else if (SAMPLE || seg == NSEG - 1) {
        float* stout = F.out + (SAMPLE ? O_SS + ((size_t)(l * 16 + b) * 16 + h) * 8192 : O_SP + ((size_t)(l * 4 + b) * 16 + h) * 8192);
#pragma unroll
        for (int j = 0; j < 8; ++j)
#pragma unroll
            for (int i = 0; i < 4; ++i) stout[(size_t)(16 * w4 + fr) * 128 + 16 * j + 4 * q4 + i] = hacc[j][i];
    }
    WG_BAR();
}

__device__ __forceinline__ void p2_conv(Frame& F, KArgs a, int l) {
    const bf16* XBC = (const bf16*)(F.ws + WS_XBC); bf16* CX = (bf16*)((unsigned char*)F.out + OUT_CX_BYTES);
    const int t = (255 - F.vcu) * 512 + F.tid;
    if (t >= 512 * 192 + 16 * 192) return;
    const bool smp = t >= 512 * 192; const int ts = smp ? t - 512 * 192 : t;
    const int rb = ts / 192, ccol = (ts % 192) * 8;
    const int row0 = smp ? MP + rb * 16 : rb * 32, nrow = smp ? 16 : 32;
    float cw[4][8], cb[8];
#pragma unroll
    for (int w = 0; w < 4; ++w) { const f32x4 t0 = *(const f32x4*)(a->in[9] + (size_t)(l * 4 + w) * 1536 + ccol), t1 = *(const f32x4*)(a->in[9] + (size_t)(l * 4 + w) * 1536 + ccol + 4);
        cw[w][0] = t0[0]; cw[w][1] = t0[1]; cw[w][2] = t0[2]; cw[w][3] = t0[3]; cw[w][4] = t1[0]; cw[w][5] = t1[1]; cw[w][6] = t1[2]; cw[w][7] = t1[3]; }
    { const f32x4 t0 = *(const f32x4*)(a->in[10] + (size_t)l * 1536 + ccol), t1 = *(const f32x4*)(a->in[10] + (size_t)l * 1536 + ccol + 4);
        cb[0] = t0[0]; cb[1] = t0[1]; cb[2] = t0[2]; cb[3] = t0[3]; cb[4] = t1[0]; cb[5] = t1[1]; cb[6] = t1[2]; cb[7] = t1[3]; }
    v4u raw[8];
#pragma unroll
    for (int k = 0; k < 8; ++k) raw[k] = __builtin_nontemporal_load((const v4u*)(XBC + (size_t)(row0 + k) * 1536 + ccol));
    float win[3][8];
    if (smp) {
#pragma unroll
        for (int k = 0; k < 3; ++k) { const float* hp_ = a->in[4] + ((size_t)(l * 16 + rb) * 3 + k) * 1536 + ccol; const f32x4 h0 = *(const f32x4*)hp_, h1 = *(const f32x4*)(hp_ + 4);
            win[k][0] = h0[0]; win[k][1] = h0[1]; win[k][2] = h0[2]; win[k][3] = h0[3]; win[k][4] = h1[0]; win[k][5] = h1[1]; win[k][6] = h1[2]; win[k][7] = h1[3]; }
    } else if ((row0 & 4095) != 0) {
#pragma unroll
        for (int k = 0; k < 3; ++k) unpk8(*(const v4u*)(XBC + (size_t)(row0 - 3 + k) * 1536 + ccol), win[k]);
    } else {
#pragma unroll
        for (int k = 0; k < 3; ++k)
#pragma unroll
            for (int e = 0; e < 8; ++e) win[k][e] = 0.f;
    }
    const int nq = nrow / 8;
    for (int qb = 0; qb < nq; ++qb) {
        v4u nxt[8];
        const int rn = row0 + ((qb + 1 < nq) ? (qb + 1) * 8 : qb * 8);
#pragma unroll
        for (int k = 0; k < 8; ++k) nxt[k] = __builtin_nontemporal_load((const v4u*)(XBC + (size_t)(rn + k) * 1536 + ccol));
#pragma unroll
        for (int jr = 0; jr < 8; ++jr) { float cur[8], o[8]; unpk8(raw[jr], cur);
#pragma unroll
            for (int e = 0; e < 8; ++e) { float v = cb[e] + cw[0][e] * win[0][e] + cw[1][e] * win[1][e] + cw[2][e] * win[2][e] + cw[3][e] * cur[e];
                o[e] = v * sigm(v); win[0][e] = win[1][e]; win[1][e] = win[2][e]; win[2][e] = cur[e]; }
            v4u pk; pk.x = cvtpk(o[0], o[1]); pk.y = cvtpk(o[2], o[3]); pk.z = cvtpk(o[4], o[5]); pk.w = cvtpk(o[6], o[7]);
            *(v4u*)(CX + (size_t)(row0 + qb * 8 + jr) * 1536 + ccol) = pk; }
#pragma unroll
        for (int k = 0; k < 8; ++k) raw[k] = nxt[k];
    }
}
__device__ __forceinline__ void p2_mixers_a(Frame& F, KArgs a, int l) {
    const int v = F.vcu, seg = v & 7;
    if (seg < NSEG - 1) ssd_unit<1>(F, a, l, v >> 6, (v >> 3) & 7, seg);
}
__device__ __forceinline__ void p2_attention(Frame& F, KArgs a, int l) {
    const int v = F.vcu;
    attn_tables(F, a);
    for (int i = 0; i < 3; ++i) { const int u = i < 2 ? 2 * v + i : 512 + v;
        if (u >= 544) break;
        if (u < 512) attn_unit<false>(F, a, l, u >> 7, (u >> 1) & 63, u & 1);
        else attn_unit<true>(F, a, l, (u - 512) >> 1, 0, u & 1); }
    const bf16* XBC = (const bf16*)(F.ws + WS_XBC);
    for (int e = v * 512 + F.tid; e < 20 * 3 * 1536; e += 256 * 512) {
        const int ch = e % 1536, j = (e / 1536) % 3, s = e / 4608;
        if (s < 4) F.out[O_CP + ((size_t)(l * 4 + s) * 3 + j) * 1536 + ch] = bf2f(XBC[(size_t)(s * 4096 + 4093 + j) * 1536 + ch]);
        else F.out[O_CS + ((size_t)(l * 16 + s - 4) * 3 + j) * 1536 + ch] = bf2f(XBC[(size_t)(MP + (s - 4) * 16 + 13 + j) * 1536 + ch]);
    }
}
__device__ __forceinline__ void p2_mixers_b(Frame& F, KArgs a, int l) {
    const int v = F.vcu;
    ssd_unit<0>(F, a, l, v >> 6, (v >> 3) & 7, v & 7);
    FRAME_REOPAQUE(F);
    if ((v & 7) < 4) { const int u = (v >> 3) * 4 + (v & 3); ssd_unit<2>(F, a, l, u >> 3, u & 7, 0); }
}

template <int NSTEP>
__device__ __forceinline__ void mini_acc(f32x4 (&acc)[4], const bf16* A, int lda, const bf16* W, int ldw, int row0, int pn, int wc, int kbase, int lane) {
    const int fr = lane & 15, q4 = lane >> 4;
    const bf16* ap = A + (size_t)(row0 + fr) * lda + kbase + 8 * q4;
    const bf16* wp = W + (size_t)(256 * pn + 32 * wc + fr) * ldw + kbase + 8 * q4;
#pragma unroll
    for (int s0 = 0; s0 < NSTEP; s0 += 4) {
        constexpr int NB = 4;
        bf16x8 af[NB], wf[NB][4];
#pragma unroll
        for (int q = 0; q < NB; ++q) { if (s0 + q < NSTEP) { af[q] = *(const bf16x8*)(ap + 32 * (s0 + q));
#pragma unroll
            for (int ct = 0; ct < 4; ++ct) wf[q][ct] = *(const bf16x8*)(wp + (size_t)(128 * (ct >> 1) + 16 * (ct & 1)) * ldw + 32 * (s0 + q)); } }
        asm volatile("" ::: "memory");
#pragma unroll
        for (int q = 0; q < NB; ++q) { if (s0 + q < NSTEP) {
#pragma unroll
            for (int ct = 0; ct < 4; ++ct) acc[ct] = MFMA16(af[q], wf[q][ct], acc[ct]); } }
    }
}
__device__ __forceinline__ void mini_reduce(Frame& F, const f32x4 (&acc)[4], LAS float* red, f32x4& v) {
#pragma unroll
    for (int ct = 0; ct < 4; ++ct)
#pragma unroll
        for (int i = 0; i < 4; ++i) red[((F.wave * 4 + ct) * 4 + i) * 64 + F.lane] = acc[ct][i];
    __syncthreads();
    v = (f32x4){0.f, 0.f, 0.f, 0.f};
    if (F.wave < 4) {
#pragma unroll
        for (int w = 0; w < 8; ++w)
#pragma unroll
            for (int i = 0; i < 4; ++i) v[i] += red[((w * 4 + F.wave) * 4 + i) * 64 + F.lane];
    }
}
__device__ __forceinline__ void mini_merge(Frame& F) {
    const int v_ = F.vcu, rb = v_ >> 4, cs = v_ & 15, pn = cs >> 2, wc = cs & 3, row0 = MP + 16 * rb;
    f32x4 a1[4], a2[4];
#pragma unroll
    for (int ct = 0; ct < 4; ++ct) { a1[ct] = (f32x4){0.f, 0.f, 0.f, 0.f}; a2[ct] = (f32x4){0.f, 0.f, 0.f, 0.f}; }
    mini_acc<2>(a1, (const bf16*)(F.ws + WS_Q), OY_LD, (const bf16*)(F.ws + WS_WATT), 1536, row0, pn, wc, F.wave * 64, F.lane);
    mini_acc<4>(a2, (const bf16*)(F.ws + WS_Q) + OY_Z, OY_LD, (const bf16*)(F.ws + WS_WATT) + 512, 1536, row0, pn, wc, F.wave * 128, F.lane);
    f32x4 v1, v2;
    mini_reduce(F, a1, (LAS float*)F.lds, v1);
    mini_reduce(F, a2, (LAS float*)(F.lds + 32768), v2);
    if (F.wave < 4) { const int ct = F.wave, col = 256 * pn + 128 * (ct >> 1) + 32 * wc + 16 * (ct & 1) + (F.lane & 15);
        const bf16* GA = (const bf16*)(F.ws + WS_GA); const bf16* GS = (const bf16*)(F.ws + WS_GS); bf16* MG = (bf16*)(F.ws + WS_MG);
#pragma unroll
        for (int i = 0; i < 4; ++i) { const int row = row0 + 4 * (F.lane >> 4) + i; const size_t off = (size_t)row * 1024 + col;
            const float rs = epi::row_rs((const float*)(F.ws + WS_SSQY), row);
            MG[off] = (unsigned short)(cvtpk(bf2f(GA[off]) * v1[i] + bf2f(GS[off]) * (v2[i] * rs), 0.f) & 0xffffu); } }
    __syncthreads();
}
template <int NSTEP>
__device__ __forceinline__ void mini_res(Frame& F, const bf16* A, int K, const bf16* W, int ssq_off) {
    const int v_ = F.vcu, rb = v_ >> 4, cs = v_ & 15, pn = cs >> 2, wc = cs & 3, row0 = MP + 16 * rb;
    f32x4 a1[4];
#pragma unroll
    for (int ct = 0; ct < 4; ++ct) a1[ct] = (f32x4){0.f, 0.f, 0.f, 0.f};
    mini_acc<NSTEP>(a1, A, K, W, K, row0, pn, wc, F.wave * (32 * NSTEP), F.lane);
    f32x4 v1;
    mini_reduce(F, a1, (LAS float*)F.lds, v1);
    LAS float* part = (LAS float*)(F.lds + 32768);
    if (F.wave < 4) { const int ct = F.wave, col = 256 * pn + 128 * (ct >> 1) + 32 * wc + 16 * (ct & 1) + (F.lane & 15);
        bf16* XB = (bf16*)(F.ws + WS_XB);
#pragma unroll
        for (int i = 0; i < 4; ++i) { const int rl = 4 * (F.lane >> 4) + i, row = row0 + rl; const size_t off = (size_t)row * 1024 + col;
            const float h = bf2f(XB[off]) + v1[i];
            XB[off] = (unsigned short)(cvtpk(h, 0.f) & 0xffffu);
            float s = h * h; s += shx(s, 1, F.lane); s += shx(s, 2, F.lane); s += shx(s, 4, F.lane); s += shx(s, 8, F.lane);
            if ((F.lane & 15) == 0) part[ct * 16 + rl] = s; } }
    __syncthreads();
    if (F.tid < 16) ((float*)(F.ws + ssq_off))[(size_t)(row0 + F.tid) * 16 + cs] = (part[F.tid] + part[16 + F.tid]) + (part[32 + F.tid] + part[48 + F.tid]);
    __syncthreads();
}

__global__ void __launch_bounds__(NWAVES * 64, 2) enc_fwd(Args args) {
    extern __shared__ __attribute__((aligned(16))) unsigned char lds[];
    Frame F;
    F.lds = (LAS unsigned char*)lds;
    F.MISC = (volatile LAS unsigned*)(F.lds + MISC_OFF);
    F.tid = threadIdx.x; F.lane = F.tid & 63; F.wave = __builtin_amdgcn_readfirstlane(F.tid >> 6);
    F.G = gridDim.x; { const int bx = blockIdx.x; F.vcu = (F.G % 8 == 0) ? (bx % 8) * (F.G / 8) + bx / 8 : bx; }
    F.ctl = (gu32*)(args.ws + WS_CTL);
    for (int u = F.tid; u < (LDS_BYTES - LDSCTL_OFF) / 4; u += NWAVES * 64) ((LAS unsigned*)(F.lds + LDSCTL_OFF))[u] = 0u;
    __syncthreads();
    XcdBarrier bar; bar.bar = (unsigned*)(F.ctl + CW_BAR); bar.x = 0; bar.st = nullptr;
    if (!MK_SPLIT) bar = xcd_barrier_post((unsigned*)(F.ctl + CW_BAR), F.MISC + 8);
    const int lo = args.ph_lo, hi = args.ph_hi;
#if PROBE_MASK
    unsigned long long pr_acc = 0ull, pr_prev = rt();
#endif
    for (int ph = lo; ph < hi; ++ph) {
        if (ph == 9 && !MK_SPLIT) continue;
        if (ph > lo && !MK_SPLIT) xcd_barrier(bar);
#if PROBE_MASK
        { const unsigned long long now_ = rt(); if (ph > lo && ((PROBE_MASK >> ((ph - 1) == NPHASE - 1 ? 9 : (ph - 1) % 9)) & 1)) pr_acc += now_ - pr_prev; pr_prev = now_; }
#endif
        { int tv = threadIdx.x; asm volatile("" : "+v"(tv)); F.tid = tv; F.lane = tv & 63; F.wave = __builtin_amdgcn_readfirstlane(tv >> 6); }
        KArgs ka = (KArgs)__builtin_amdgcn_kernarg_segment_ptr(); asm volatile("" : "+s"(ka));
        unsigned char* ws = ka->ws; float* outp = ka->out; F.ws = ws; F.out = outp;
        const int l = ph / 9, k = ph % 9;
        if (PH_EN(9) && ph == NPHASE - 1) {
            const int gw = F.vcu * NWAVES + F.wave, NGW = F.G * NWAVES;
            for (int m = gw; m < MALL; m += NGW) {
                const float rs = epi::row_rs((const float*)(ws + WS_SSQX), m);
                GAS f32x4* yr = (GAS f32x4*)(outp + (size_t)m * DM) + F.lane; const GAS f32x4* gr = (const GAS f32x4*)ka->in[23] + F.lane;
                const GAS unsigned long long* xb = (const GAS unsigned long long*)((const bf16*)(ws + WS_XB) + (size_t)m * DM) + F.lane;
#pragma unroll
                for (int j = 0; j < 4; ++j) { const unsigned long long w = __builtin_nontemporal_load(xb + 64 * j); const f32x4 gg = gr[64 * j];
                    f32x4 v = (f32x4){__uint_as_float((unsigned)w << 16), __uint_as_float((unsigned)w & 0xffff0000u), __uint_as_float((unsigned)(w >> 32) << 16), __uint_as_float((unsigned)(w >> 32) & 0xffff0000u)};
                    v = v * rs * gg; __builtin_nontemporal_store(v, (f32x4*)(outp + (size_t)m * DM) + F.lane + 64 * j); }
            }
        } else if (PH_EN(0) && k == 0) { p0_convert(F, ka, l);
        } else if (PH_EN(1) && k == 1) {
            if (l == 1 && !MK_SPLIT) { p0_convert_slack<1>(F, ka, 1); __syncthreads(); FRAME_REOPAQUE(F); }
            if (l == 0 && !MK_SPLIT) { p0_convert_slack<2>(F, ka, 0); __syncthreads(); FRAME_REOPAQUE(F); }
            pg8::Gemm g{(const bf16*)(ws + WS_XB), (const bf16*)(ws + WS_WIN), MALL, NU, 1024}; pg8::StaticOrder S; S.init(MALL, NU, F.G, (int)blockIdx.x);
            epi::EpiIn E{ws, ka->in[11] + l * 16};
            pg8::gemm_phase<epi::EpiIn, pg8::StaticOrder, true, true>(F.lds, g, S, E);
        } else if (PH_EN(2) && k == 2) { p2_conv(F, ka, l); FRAME_REOPAQUE(F); p2_attention(F, ka, l);
        } else if (PH_EN(3) && k == 3) { p2_mixers_a(F, ka, l);
        } else if (PH_EN(4) && k == 4) { p2_mixers_b(F, ka, l);
        } else if (PH_EN(5) && k == 5) {
            { pg8::Gemm g{(const bf16*)(ws + WS_Q), (const bf16*)(ws + WS_WATT), MP, 1024, 1536}; pg8::StaticOrder S; S.init(MP, 1024, F.G, (int)blockIdx.x);
              { pg8::Unit u0; if (S.next(0, u0) && F.tid < 256) EPI_RSL[F.tid] = epi::row_rs((const float*)(ws + WS_SSQY), u0.pm * 256 + F.tid); }
              __syncthreads();
              epi::EpiMerge E{ws}; pg8::gemm_phase<epi::EpiMerge, pg8::StaticOrder, true, true>(F.lds, g, S, E); }
            FRAME_REOPAQUE(F); mini_merge(F);
        } else if (PH_EN(6) && k == 6) {
            pg8::Gemm g{(const bf16*)(ws + WS_MG), (const bf16*)(ws + WS_WOUT), MP, 1024, 1024}; pg8::StaticOrder S; S.init(MP, 1024, F.G, (int)blockIdx.x);
            epi::EpiRes E{ws, (int)WS_SSQH};
            pg8::gemm_phase<epi::EpiRes, pg8::StaticOrder, false, true>(F.lds, g, S, E);
            FRAME_REOPAQUE(F); mini_res<4>(F, (const bf16*)(ws + WS_MG), 1024, (const bf16*)(ws + WS_WOUT), (int)WS_SSQH);
        } else if (PH_EN(7) && k == 7) {
            pg8::Gemm g{(const bf16*)(ws + WS_XB), (const bf16*)(ws + WS_WGU), MALL, NU, 1024}; pg8::StaticOrder S; S.init(MALL, NU, F.G, (int)blockIdx.x);
            epi::EpiGlu E{ws};
            if (l == 0 && !MK_SPLIT) { p0_convert_slack<0>(F, ka, 1); __syncthreads(); FRAME_REOPAQUE(F); }
            pg8::gemm_phase<epi::EpiGlu, pg8::StaticOrder, true, true>(F.lds, g, S, E);
        } else if (PH_EN(8) && k == 8) {
            pg8::Gemm g{(const bf16*)(ws + WS_ACT), (const bf16*)(ws + WS_WDN), MP, 1024, DFF}; pg8::StaticOrder S; S.init(MP, 1024, F.G, (int)blockIdx.x);
            epi::EpiRes E{ws, (int)WS_SSQX};
            pg8::gemm_phase<epi::EpiRes, pg8::StaticOrder, false, true>(F.lds, g, S, E);
            FRAME_REOPAQUE(F); mini_res<11>(F, (const bf16*)(ws + WS_ACT), DFF, (const bf16*)(ws + WS_WDN), (int)WS_SSQX);
        }
    }
#if PROBE_MASK
    { const unsigned long long now_ = rt(); if ((PROBE_MASK >> ((hi - 1) == NPHASE - 1 ? 9 : (hi - 1) % 9)) & 1) pr_acc += now_ - pr_prev;
      if (blockIdx.x == 0) { const unsigned long long t0_ = rt(); while (rt() - t0_ < (unsigned long long)PROBE_K * pr_acc) __builtin_amdgcn_s_sleep(8); } }
#endif
}

extern "C" void kernel_launch(void* const* d_in, const int* in_sizes, int n_in, void* d_out, int out_size, void* d_ws, size_t ws_size, hipStream_t stream) {
    static int ready = 0;
    if (ready == 0) {
        if (n_in != 24 || out_size != (int)O_END || ws_size < WS_END) { fprintf(stderr, "kernel_launch: unexpected problem shape (n_in %d, out %d, ws %zu); nothing launched\n", n_in, out_size, ws_size); ready = -1; return; }
        if (hipFuncSetAttribute((const void*)enc_fwd, hipFuncAttributeMaxDynamicSharedMemorySize, LDS_BYTES) != hipSuccess) { fprintf(stderr, "kernel_launch: hipFuncSetAttribute failed\n"); ready = -1; return; }
        { int dev = 0, cus = 0, per_cu = 0;
          if (hipGetDevice(&dev) == hipSuccess && hipDeviceGetAttribute(&cus, hipDeviceAttributeMultiprocessorCount, dev) == hipSuccess && cus < 256)
              fprintf(stderr, "kernel_launch: this kernel needs 256 co-resident workgroups (one per CU); the device reports %d CUs: the grid barrier would give up and the output would be wrong\n", cus);
          if (hipOccupancyMaxActiveBlocksPerMultiprocessor(&per_cu, (const void*)enc_fwd, NWAVES * 64, LDS_BYTES) != hipSuccess || per_cu < 1)
              fprintf(stderr, "kernel_launch: note: the occupancy query reports %d workgroups per CU for %d B of LDS\n", per_cu, LDS_BYTES); }
        (void)hipGetLastError();
        ready = 1;
    }
    if (ready < 0) return;
    if (hipMemsetAsync((char*)d_ws + WS_CTL, 0, CTL_ZERO_BYTES, stream) != hipSuccess) { fprintf(stderr, "kernel_launch: hipMemsetAsync failed\n"); return; }
    Args a{};
    for (int i = 0; i < 24; ++i) a.in[i] = (const float*)d_in[i];
    a.out = (float*)d_out; a.ws = (unsigned char*)d_ws;
#if MK_SPLIT
    for (int ph = 0; ph < NPHASE; ++ph) { a.ph_lo = ph; a.ph_hi = ph + 1; a.li = ph; hipLaunchKernelGGL(enc_fwd, dim3(256), dim3(NWAVES * 64), LDS_BYTES, stream, a); }
#else
    a.ph_lo = 0; a.ph_hi = NPHASE; a.li = 0;
    hipLaunchKernelGGL(enc_fwd, dim3(256), dim3(NWAVES * 64), LDS_BYTES, stream, a);
#endif
    const hipError_t le = hipPeekAtLastError();
    if (le != hipSuccess) fprintf(stderr, "kernel_launch: launch failed: %s\n", hipGetErrorName(le));
}
```

```cpp
#include <hip/hip_runtime.h>
#include <cstdio>
#include <cstdint>
namespace pg8 {
#define PG8_LAS __attribute__((address_space(3)))
typedef unsigned short bf16_t;
typedef short bf16x8 __attribute__((ext_vector_type(8)));
typedef float f32x4 __attribute__((ext_vector_type(4)));
typedef unsigned u32x4 __attribute__((ext_vector_type(4)));
constexpr int BM = 256, BK = 64, HALF = 128, HTB = HALF * BK * 2  , STAGE_BYTES = 8 * HTB, NXCD = 8, WGM = 2;

__host__ __device__ __forceinline__ int lds_byte(int r, int c) { const int st = (r >> 4) * 2 + (c >> 5), rr = r & 15, cc = c & 31, ob = rr * 64 + cc * 2; return st * 1024 + (ob ^ (((ob >> 9) & 1) << 5)); }
__host__ __device__ __forceinline__ void stage_rc(int b, int& R, int& C) { const int st = b / 1024, sb = b % 1024, swz = sb ^ (((sb >> 9) & 1) << 5); R = (st >> 1) * 16 + swz / 64; C = (st & 1) * 32 + (swz % 64) / 2; }
__host__ __device__ __forceinline__ int perm32(int rho) { const int n = rho >> 4, i = rho & 15; return 8 * (i >> 2) + 4 * n + (i & 3); }

struct Unit { int pm, pn; };
struct Gemm { const bf16_t* A; const bf16_t* Bt; int M, N, K; };

struct StaticOrder {
    int nM, nN, nwg, G, c;
    __host__ __device__ void init(int M, int N, int G_, int c_) { nM = M / BM; nN = N / BM; nwg = nM * nN; G = G_; c = c_; }
    __host__ __device__ bool next(int i, Unit& u) const {
        const long L = (long)i * G + c; if (L >= nwg) return false;
        int wgid = (int)L; { const int q = nwg / NXCD, r = nwg % NXCD, xcd = wgid % NXCD, off = wgid / NXCD; wgid = (xcd < r ? xcd * (q + 1) : r * (q + 1) + (xcd - r) * q) + off; }
        const int nig = WGM * nN, gid = wgid / nig, fm = gid * WGM, gsz = (nM - fm) < WGM ? (nM - fm) : WGM;
        u.pm = fm + ((wgid % nig) % gsz); u.pn = (wgid % nig) / gsz; return true;
    }
    __device__ __forceinline__ void a_ready(const Unit&) const {}
    __device__ __forceinline__ void done(const Unit&) const {}
};

__device__ __forceinline__ unsigned cvt_pk_bf16(float lo, float hi) { unsigned r; asm volatile("v_cvt_pk_bf16_f32 %0, %1, %2" : "=v"(r) : "v"(lo), "v"(hi)); return r; }
typedef float f32x2 __attribute__((ext_vector_type(2)));
template <class Epi, class Sched, bool ALIGN_EPI = false, bool SP2 = false>
__device__ __forceinline__ void gemm_phase(PG8_LAS unsigned char* lds, const Gemm g, const Sched& S, const Epi& E) {
    int tid_ = threadIdx.x; asm volatile("" : "+v"(tid_));
    const int tid = tid_, wid = __builtin_amdgcn_readfirstlane(tid >> 6), lane = tid & 63, wr = wid >> 2, wc = wid & 3, fr = lane & 15, fq = lane >> 4;
    const int K = g.K, nt = K / BK;
    unsigned voffA[2], voffB[2];
#pragma unroll
    for (int i = 0; i < 2; ++i) { int R, C; stage_rc(tid * 16 + i * 8192, R, C); const int Rb = Epi::PERM ? ((R & ~31) + perm32(R & 31)) : R;
        voffA[i] = (unsigned)(R * K + C) * 2u; voffB[i] = (unsigned)(Rb * K + C) * 2u; }
    const size_t kstep = (size_t)(BK * 2);
    const size_t hstep = (size_t)HALF * K * 2;
    const size_t tstep = 2 * hstep;
    const unsigned ldsw = (unsigned)wid * 1024u;
    const int aoff = lds_byte(wr * 64 + fr, fq * 8), boff = lds_byte(wc * 32 + fr, fq * 8);
#define PG8_SA(b, h) (((b) * 2 + (h)) * HTB)
#define PG8_SB(b, h) ((4 + (b) * 2 + (h)) * HTB)
#define PG8_STAGE(bufoff, gbase, voff) do { _Pragma("unroll") for (int _i = 0; _i < 2; ++_i) \
        __builtin_amdgcn_global_load_lds((const unsigned*)((const char*)(gbase) + (voff)[_i]), (PG8_LAS unsigned*)(lds + (bufoff) + ldsw + _i * 8192), 16, 0, 0); } while (0)
#define PG8_LDA(dst, b, h) do { _Pragma("unroll") for (int m = 0; m < 4; ++m) _Pragma("unroll") for (int k = 0; k < 2; ++k) dst[m][k] = *(const PG8_LAS bf16x8*)(lds + PG8_SA(b, h) + aoff + m * 2048 + k * 1024); } while (0)
#define PG8_LDB(dst, b, h) do { _Pragma("unroll") for (int n = 0; n < 2; ++n) _Pragma("unroll") for (int k = 0; k < 2; ++k) dst[n][k] = *(const PG8_LAS bf16x8*)(lds + PG8_SB(b, h) + boff + n * 2048 + k * 1024); } while (0)
#define PG8_MMA(ai, bj, At, Bt) do { __builtin_amdgcn_s_setprio(1); _Pragma("unroll") for (int m = 0; m < 4; ++m) _Pragma("unroll") for (int n = 0; n < 2; ++n) _Pragma("unroll") for (int k = 0; k < 2; ++k) \
        acc[ai][bj][m][n] = __builtin_amdgcn_mfma_f32_16x16x32_bf16(Bt[n][k], At[m][k], acc[ai][bj][m][n], 0, 0, 0); __builtin_amdgcn_s_setprio(0); } while (0)
#define PG8_WAIT_V(n) asm volatile("s_waitcnt vmcnt(" #n ")" ::: "memory")
#define PG8_WAIT_L(n) asm volatile("s_waitcnt lgkmcnt(" #n ")" ::: "memory")
#define PG8_BAR __builtin_amdgcn_s_barrier()
#define PG8_SCHED __builtin_amdgcn_sched_barrier(0)
    Unit cur, nxt; int ui = 0;
    if (!S.next(0, cur)) return;
    f32x4 acc[2][2][4][2];
#pragma unroll
    for (int a = 0; a < 2; ++a)
#pragma unroll
        for (int b = 0; b < 2; ++b)
#pragma unroll
            for (int m = 0; m < 4; ++m)
#pragma unroll
                for (int n = 0; n < 2; ++n) acc[a][b][m][n] = (f32x4){0.f, 0.f, 0.f, 0.f};
    bf16x8 At[4][2], B0[2][2], B1[2][2];
    const char* cA = (const char*)g.A + (size_t)cur.pm * tstep; const char* cB = (const char*)g.Bt + (size_t)cur.pn * tstep;
    S.a_ready(cur);
    if constexpr (SP2) {
        PG8_STAGE(PG8_SB(0, 0), cB, voffB); PG8_STAGE(PG8_SB(0, 1), cB + hstep, voffB); PG8_STAGE(PG8_SA(0, 0), cA, voffA); PG8_STAGE(PG8_SA(0, 1), cA + hstep, voffA);
        if (wr == 1) PG8_BAR;
        PG8_WAIT_V(2); PG8_BAR;
        PG8_STAGE(PG8_SB(1, 0), cB + kstep, voffB); PG8_STAGE(PG8_SA(1, 0), cA + kstep, voffA); PG8_STAGE(PG8_SB(1, 1), cB + hstep + kstep, voffB);
        PG8_WAIT_V(6); PG8_BAR;
    } else {
        PG8_STAGE(PG8_SB(0, 0), cB, voffB); PG8_STAGE(PG8_SA(0, 0), cA, voffA); PG8_STAGE(PG8_SB(0, 1), cB + hstep, voffB); PG8_STAGE(PG8_SA(0, 1), cA + hstep, voffA);
        if (wr == 1) PG8_BAR;
        PG8_WAIT_V(4); PG8_BAR;
        PG8_STAGE(PG8_SB(1, 0), cB + kstep, voffB); PG8_STAGE(PG8_SA(1, 0), cA + kstep, voffA); PG8_STAGE(PG8_SB(1, 1), cB + hstep + kstep, voffB);
        PG8_WAIT_V(6); PG8_BAR;
    }
    for (;;) {
        const bool has_next = S.next(ui + 1, nxt);
        const char* nA = has_next ? (const char*)g.A + (size_t)nxt.pm * tstep : cA; const char* nB = has_next ? (const char*)g.Bt + (size_t)nxt.pn * tstep : cB;
        for (int t = 0; t < nt; t += 2) {
            const bool last = (t == nt - 2);
            const char* a1 = cA + (size_t)(t + 1) * kstep;
            const char* a2 = last ? nA : cA + (size_t)(t + 2) * kstep; const char* b2 = last ? nB : cB + (size_t)(t + 2) * kstep;
            const char* a3 = a2 + kstep; const char* b3 = b2 + kstep;
            if (last && has_next) S.a_ready(nxt);
            if constexpr (SP2) {
            PG8_LDB(B0, 0, 0); PG8_LDB(B1, 0, 1); PG8_SCHED; PG8_LDA(At, 0, 0); PG8_STAGE(PG8_SA(1, 1), a1 + hstep, voffA);
            PG8_WAIT_V(8); PG8_WAIT_L(0); PG8_BAR; PG8_MMA(0, 0, At, B0); PG8_MMA(0, 1, At, B1); PG8_BAR; PG8_SCHED;
            PG8_LDA(At, 0, 1); PG8_STAGE(PG8_SB(0, 0), b2, voffB); PG8_STAGE(PG8_SB(0, 1), b2 + hstep, voffB); PG8_STAGE(PG8_SA(0, 0), a2, voffA);
            PG8_WAIT_V(8); PG8_WAIT_L(0); PG8_BAR; PG8_MMA(1, 0, At, B0); PG8_MMA(1, 1, At, B1); PG8_BAR; PG8_SCHED;
            PG8_LDB(B0, 1, 0); PG8_LDB(B1, 1, 1); PG8_SCHED; PG8_LDA(At, 1, 0); PG8_STAGE(PG8_SA(0, 1), a2 + hstep, voffA);
            PG8_WAIT_V(8); PG8_WAIT_L(0); PG8_BAR; PG8_MMA(0, 0, At, B0); PG8_MMA(0, 1, At, B1); PG8_BAR; PG8_SCHED;
            PG8_LDA(At, 1, 1); PG8_STAGE(PG8_SB(1, 0), b3, voffB); PG8_STAGE(PG8_SB(1, 1), b3 + hstep, voffB); PG8_STAGE(PG8_SA(1, 0), a3, voffA);
            PG8_WAIT_V(8); PG8_WAIT_L(0); PG8_BAR; PG8_MMA(1, 0, At, B0); PG8_MMA(1, 1, At, B1); PG8_BAR; PG8_SCHED;
            } else {
            PG8_LDB(B0, 0, 0); PG8_SCHED; PG8_LDA(At, 0, 0); PG8_STAGE(PG8_SA(1, 1), a1 + hstep, voffA);
            PG8_WAIT_L(8); PG8_BAR; PG8_WAIT_L(0); PG8_MMA(0, 0, At, B0); PG8_BAR; PG8_SCHED;
            PG8_LDB(B1, 0, 1); PG8_STAGE(PG8_SB(0, 0), b2, voffB);
            PG8_BAR; PG8_WAIT_L(0); PG8_MMA(0, 1, At, B1); PG8_BAR;
            PG8_LDA(At, 0, 1); PG8_STAGE(PG8_SA(0, 0), a2, voffA);
            PG8_BAR; PG8_WAIT_L(0); PG8_MMA(1, 0, At, B0); PG8_BAR; PG8_SCHED;
            PG8_STAGE(PG8_SB(0, 1), b2 + hstep, voffB);
            PG8_WAIT_V(6); PG8_BAR; PG8_MMA(1, 1, At, B1); PG8_BAR;
            PG8_LDB(B0, 1, 0); PG8_SCHED; PG8_LDA(At, 1, 0); PG8_STAGE(PG8_SA(0, 1), a2 + hstep, voffA);
            PG8_WAIT_L(8); PG8_BAR; PG8_WAIT_L(0); PG8_MMA(0, 0, At, B0); PG8_BAR; PG8_SCHED;
            PG8_LDB(B1, 1, 1); PG8_STAGE(PG8_SB(1, 0), b3, voffB);
            PG8_BAR; PG8_WAIT_L(0); PG8_MMA(0, 1, At, B1); PG8_BAR;
            PG8_LDA(At, 1, 1); PG8_STAGE(PG8_SA(1, 0), a3, voffA);
            PG8_BAR; PG8_WAIT_L(0); PG8_MMA(1, 0, At, B0); PG8_BAR; PG8_SCHED;
            PG8_STAGE(PG8_SB(1, 1), b3 + hstep, voffB);
            PG8_WAIT_V(6); PG8_BAR; PG8_MMA(1, 1, At, B1); PG8_BAR;
            }
            if constexpr (Epi::HOOK_T > 0) { if (t + 2 == Epi::HOOK_T) E.mid(acc, cur, wr, wc, fr, fq); }
        }
        if constexpr (ALIGN_EPI) { if (wr == 0) PG8_BAR; }
        if constexpr (!Epi::AFTER_DRAIN) { E(acc, cur, wr, wc, fr, fq); S.done(cur); }
        if (!has_next) break;
#pragma unroll
        for (int a = 0; a < 2; ++a)
#pragma unroll
            for (int b = 0; b < 2; ++b)
#pragma unroll
                for (int m = 0; m < 4; ++m)
#pragma unroll
                    for (int n = 0; n < 2; ++n) acc[a][b][m][n] = (f32x4){0.f, 0.f, 0.f, 0.f};
        cur = nxt; cA = nA; cB = nB; ++ui;
        if constexpr (ALIGN_EPI) { if (wr == 1) PG8_BAR; }
    }
    PG8_WAIT_V(0);
    if constexpr (!ALIGN_EPI) { if (wr == 0) PG8_BAR; }
    PG8_BAR;
    if constexpr (Epi::AFTER_DRAIN) { E.fused(acc, cur, wr, wc, fr, fq, lds, wid, lane); S.done(cur); }
#undef PG8_SA
#undef PG8_SB
#undef PG8_STAGE
#undef PG8_LDA
#undef PG8_LDB
#undef PG8_MMA
#undef PG8_WAIT_V
#undef PG8_WAIT_L
#undef PG8_BAR
#undef PG8_SCHED
}
}

#ifndef MK_SPLIT
#define MK_SPLIT 0
#endif
#ifndef PH_MASK
#define PH_MASK 0x3ff
#endif
#define PH_EN(k) (((PH_MASK) >> (k)) & 1)
#ifndef MIX_MASK
#define MIX_MASK 0xf
#endif
#define MIX_EN(k) (((MIX_MASK) >> (k)) & 1)
#ifndef PROBE_MASK
#define PROBE_MASK 0
#endif
#ifndef SUBPROBE
#define SUBPROBE 0
#endif
#ifndef PROBE_K
#define PROBE_K 4
#endif
constexpr int NWAVES = 8;
constexpr int MP = 16384, MS = 256, MALL = MP + MS, DM = 1024, NU = 5632, DFF = 2816;
constexpr int NPHASE = 19;
constexpr size_t KiB = 1024, MiB = 1u << 20;
constexpr size_t WS_CTL = 0, CTL_ZERO_BYTES = 1 * MiB;
constexpr size_t WS_SSQX = 1 * MiB, WS_SSQY = WS_SSQX + 1280 * KiB, WS_SSQH = WS_SSQY + 1280 * KiB, WS_DT = WS_SSQH + 1280 * KiB;
constexpr size_t WS_WIN = 6 * MiB, WS_WGU = WS_WIN + 11 * MiB, WS_WATT = WS_WGU + 11 * MiB, WS_WSSD = WS_WATT + 1 * MiB, WS_WOUT = WS_WSSD + 2 * MiB, WS_WDN = WS_WOUT + 2 * MiB;
constexpr size_t WS_XB = WS_WDN + 5632 * KiB;
constexpr size_t WS_Q = WS_XB + (size_t)MALL * 1024 * 2;
constexpr size_t WS_KV = WS_Q + (size_t)MALL * 1536 * 2;
constexpr int OY_LD = 1536, OY_Z = 512;
constexpr size_t WS_XBC = WS_KV + (size_t)MALL * 256 * 2;
constexpr size_t WS_GA = WS_XBC + (size_t)MALL * 1536 * 2;
constexpr size_t WS_GS = WS_GA + (size_t)MALL * 1024 * 2;
constexpr size_t WS_END = WS_GS + (size_t)MALL * 1024 * 2;
constexpr size_t OUT_CX_BYTES = 14 * MiB, WS_SEGD = 512 * KiB;
static_assert(OUT_CX_BYTES + (size_t)MALL * 1536 * 2 <= (size_t)MALL * 1024 * 4 && (size_t)64 * 7 * 8192 * 4 <= OUT_CX_BYTES, "d_out scratch map");
constexpr size_t OUT_SEGE_UNUSED = 0;
constexpr size_t WS_MG = WS_XBC;
constexpr size_t WS_ACT = WS_Q;
static_assert(WS_END <= 256 * MiB, "d_ws map");
static_assert(WS_ACT + (size_t)MALL * DFF * 2 <= WS_GA, "ACT overlay");
static_assert(WS_XB % 256 == 0 && WS_Q % 256 == 0 && WS_KV % 256 == 0 && WS_XBC % 256 == 0 && WS_GA % 256 == 0, "align");
constexpr int CW_BAR = 4096;
constexpr size_t O_Y = 0, O_KP = 17039360, O_VP = 17170432, O_CP = 17301504, O_SP = 17338368, O_KS = 18386944, O_VS = 18911232, O_CS = 19435520, O_SS = 19582976, O_END = 23777280;
constexpr int RING_BYTES = 131072, LDS_BYTES = 163840, LDSCTL_OFF = LDS_BYTES - 4096, MISC_OFF = LDSCTL_OFF + 320;


__device__ __forceinline__ float bperm_f(float v, int src_lane) { return __int_as_float(__builtin_amdgcn_ds_bpermute(src_lane << 2, __float_as_int(v))); }
__device__ __forceinline__ float shx(float v, int m, int lane) { return bperm_f(v, lane ^ m); }

namespace epi {
using pg8::bf16_t; using pg8::f32x4; using pg8::u32x4; using pg8::Unit; using pg8::cvt_pk_bf16;
__device__ __forceinline__ float bflo(unsigned w) { return __uint_as_float(w << 16); }
__device__ __forceinline__ float bfhi(unsigned w) { return __uint_as_float(w & 0xffff0000u); }
__device__ __forceinline__ float sigm(float x) { return __builtin_amdgcn_rcpf(1.0f + __expf(-x)); }
__device__ __forceinline__ float row_rs(const float* ssq, int row) {
    const f32x4* p = (const f32x4*)(ssq + (size_t)row * 16);
    const f32x4 a = p[0], b = p[1], c = p[2], d = p[3];
    const float s = (((a[0] + a[1]) + (a[2] + a[3])) + ((b[0] + b[1]) + (b[2] + b[3]))) + (((c[0] + c[1]) + (c[2] + c[3])) + ((d[0] + d[1]) + (d[2] + d[3])));
    return rsqrtf(s * (1.0f / 1024.0f) + 1e-6f);
}
__device__ __forceinline__ u32x4 pack8(const f32x4 v0, const f32x4 v1) {
    u32x4 w; w.x = cvt_pk_bf16(v0[0], v0[1]); w.y = cvt_pk_bf16(v0[2], v0[3]); w.z = cvt_pk_bf16(v1[0], v1[1]); w.w = cvt_pk_bf16(v1[2], v1[3]); return w;
}
__device__ __forceinline__ void unpack8(const u32x4 w, f32x4& v0, f32x4& v1) {
    v0 = (f32x4){bflo(w.x), bfhi(w.x), bflo(w.y), bfhi(w.y)}; v1 = (f32x4){bflo(w.z), bfhi(w.z), bflo(w.w), bfhi(w.w)};
}
__device__ __forceinline__ float softplus(float x) { return fmaxf(x, 0.f) + log1pf(__expf(-fabsf(x))); }


#define EPI_RSL ((__attribute__((address_space(3))) float*)(uintptr_t)131072)
__device__ __forceinline__ void stage_rs(const float* ssq, const Unit& u, int wr, int wc, int fr, int fq) {
    const int tid = (wr * 4 + wc) * 64 + fq * 16 + fr;
    if (tid < 256) EPI_RSL[tid] = row_rs(ssq, u.pm * 256 + tid);
    asm volatile("s_waitcnt lgkmcnt(0)" ::: "memory"); __builtin_amdgcn_s_barrier(); asm volatile("" ::: "memory");
}

struct EpiIn {
    static constexpr bool PERM = true, AFTER_DRAIN = false; static constexpr int HOOK_T = 0;
    unsigned char* ws; const float* dt_bias;
    __device__ __forceinline__ void operator()(const f32x4 (&acc)[2][2][4][2], const Unit& u, int wr, int wc, int fr_, int fq_) const {
        int fr = fr_, fq = fq_; asm volatile("" : "+v"(fr), "+v"(fq));
        const int pn = u.pn, row0 = u.pm * 256 + wr * 64 + fr, cl = wc * 32 + 8 * fq;
        float* DT = (float*)(ws + WS_DT);
        stage_rs((const float*)(ws + WS_SSQX), u, wr, wc, fr, fq);
        size_t boff = WS_Q; int ldc = 512, colt = 0, mode = 0;
        if (pn < 2) { boff = WS_Q; ldc = OY_LD; colt = pn * 256; }
        else if (pn == 2) { boff = WS_KV; ldc = 256; colt = 0; }
        else if (pn < 7) { boff = WS_Q; ldc = OY_LD; colt = OY_Z + (pn - 3) * 256; }
        else if (pn < 13) { boff = WS_XBC; ldc = 1536; colt = (pn - 7) * 256; }
        else if (pn < 17) { boff = WS_GA; ldc = 1024; colt = (pn - 13) * 256; mode = 1; }
        else if (pn < 21) { boff = WS_GS; ldc = 1024; colt = (pn - 17) * 256; mode = 1; }
        else mode = 2;
        bf16_t* base = (bf16_t*)(ws + boff);
#pragma unroll
        for (int ai = 0; ai < 2; ++ai)
#pragma unroll
            for (int m = 0; m < 4; ++m) {
                const int row = row0 + ai * 128 + m * 16; const float rs = EPI_RSL[wr * 64 + fr + ai * 128 + m * 16];
                if (mode == 2) {
                    if (wc == 0 && fq < 2) {
                        const f32x4 b0 = *(const f32x4*)(dt_bias + 8 * fq), b1 = *(const f32x4*)(dt_bias + 8 * fq + 4);
                        f32x4 v0 = acc[ai][0][m][0] * rs + b0, v1 = acc[ai][0][m][1] * rs + b1;
#pragma unroll
                        for (int j = 0; j < 4; ++j) { v0[j] = softplus(v0[j]); v1[j] = softplus(v1[j]); }
                        *(f32x4*)(DT + (size_t)row * 16 + 8 * fq) = v0; *(f32x4*)(DT + (size_t)row * 16 + 8 * fq + 4) = v1;
                    }
                } else {
                    bf16_t* rowp = base + (size_t)row * ldc + colt + cl;
#pragma unroll
                    for (int bj = 0; bj < 2; ++bj) {
                        f32x4 v0 = acc[ai][bj][m][0] * rs, v1 = acc[ai][bj][m][1] * rs;
                        if (mode == 1) {
#pragma unroll
                            for (int j = 0; j < 4; ++j) { v0[j] = sigm(v0[j]); v1[j] = sigm(v1[j]); }
                        }
                        *(u32x4*)(rowp + bj * 128) = pack8(v0, v1);
                    }
                }
            }
    }
};
struct EpiMerge {
    static constexpr bool PERM = true, AFTER_DRAIN = false; static constexpr int HOOK_T = 8;
    unsigned char* ws;
    __device__ __forceinline__ void mid(f32x4 (&acc)[2][2][4][2], const Unit& u, int wr, int wc, int fr_, int fq_) const {
        int fr = fr_, fq = fq_; asm volatile("" : "+v"(fr), "+v"(fq));
        const int row0 = u.pm * 256 + wr * 64 + fr, col0 = u.pn * 256 + wc * 32 + 8 * fq;
        const bf16_t* GA = (const bf16_t*)(ws + WS_GA); const bf16_t* GS = (const bf16_t*)(ws + WS_GS);
#pragma unroll
        for (int ai = 0; ai < 2; ++ai) {
            u32x4 aq[4][2], sq[4][2];
#pragma unroll
            for (int m = 0; m < 4; ++m)
#pragma unroll
                for (int bj = 0; bj < 2; ++bj) { const size_t off = (size_t)(row0 + ai * 128 + m * 16) * 1024 + col0 + bj * 128; aq[m][bj] = *(const u32x4*)(GA + off); sq[m][bj] = *(const u32x4*)(GS + off); }
            asm volatile("" ::: "memory");
#pragma unroll
            for (int m = 0; m < 4; ++m) {
                const float rs = EPI_RSL[wr * 64 + fr + ai * 128 + m * 16];
#pragma unroll
                for (int bj = 0; bj < 2; ++bj) {
                    f32x4 a0, a1, s0, s1; unpack8(aq[m][bj], a0, a1); unpack8(sq[m][bj], s0, s1);
#pragma unroll
                    for (int j = 0; j < 4; ++j) { acc[ai][bj][m][0][j] *= a0[j] * __builtin_amdgcn_rcpf(fmaxf(s0[j] * rs, 1e-30f)); acc[ai][bj][m][1][j] *= a1[j] * __builtin_amdgcn_rcpf(fmaxf(s1[j] * rs, 1e-30f)); }
                }
            }
            asm volatile("" ::: "memory");
        }
    }
    __device__ __forceinline__ void operator()(const f32x4 (&acc)[2][2][4][2], const Unit& u, int wr, int wc, int fr_, int fq_) const {
        int fr = fr_, fq = fq_; asm volatile("" : "+v"(fr), "+v"(fq));
        const int row0 = u.pm * 256 + wr * 64 + fr, col0 = u.pn * 256 + wc * 32 + 8 * fq;
        const bf16_t* GS = (const bf16_t*)(ws + WS_GS); bf16_t* MG = (bf16_t*)(ws + WS_MG);
#pragma unroll
        for (int ai = 0; ai < 2; ++ai) {
            u32x4 sq[4][2];
#pragma unroll
            for (int m = 0; m < 4; ++m)
#pragma unroll
                for (int bj = 0; bj < 2; ++bj) sq[m][bj] = *(const u32x4*)(GS + (size_t)(row0 + ai * 128 + m * 16) * 1024 + col0 + bj * 128);
            asm volatile("" ::: "memory");
#pragma unroll
            for (int m = 0; m < 4; ++m) {
                const float rs = EPI_RSL[wr * 64 + fr + ai * 128 + m * 16];
                const size_t off = (size_t)(row0 + ai * 128 + m * 16) * 1024 + col0;
#pragma unroll
                for (int bj = 0; bj < 2; ++bj) {
                    f32x4 s0, s1; unpack8(sq[m][bj], s0, s1);
                    *(u32x4*)(MG + off + bj * 128) = pack8(acc[ai][bj][m][0] * (s0 * rs), acc[ai][bj][m][1] * (s1 * rs));
                }
            }
            asm volatile("" ::: "memory");
        }
    }
};
struct EpiRes {
    static constexpr bool PERM = true, AFTER_DRAIN = false; static constexpr int HOOK_T = 0;
    unsigned char* ws; int ssq_off;
    __device__ __forceinline__ void operator()(const f32x4 (&acc)[2][2][4][2], const Unit& u, int wr, int wc, int fr_, int fq_) const {
        int fr = fr_, fq = fq_; asm volatile("" : "+v"(fr), "+v"(fq));
        const int row0 = u.pm * 256 + wr * 64 + fr, col0 = u.pn * 256 + wc * 32 + 8 * fq;
        bf16_t* XB = (bf16_t*)(ws + WS_XB); float* ssq_out = (float*)(ws + ssq_off);
#pragma unroll
        for (int ai = 0; ai < 2; ++ai) {
            u32x4 rq[4][2];
#pragma unroll
            for (int m = 0; m < 4; ++m)
#pragma unroll
                for (int bj = 0; bj < 2; ++bj) rq[m][bj] = *(const u32x4*)(XB + (size_t)(row0 + ai * 128 + m * 16) * 1024 + col0 + bj * 128);
            asm volatile("" ::: "memory");
#pragma unroll
            for (int m = 0; m < 4; ++m) {
                const int row = row0 + ai * 128 + m * 16;
                const size_t off = (size_t)row * 1024 + col0; float ss = 0.f;
#pragma unroll
                for (int bj = 0; bj < 2; ++bj) {
                    f32x4 r0, r1; unpack8(rq[m][bj], r0, r1);
                    const f32x4 v0 = acc[ai][bj][m][0] + r0, v1 = acc[ai][bj][m][1] + r1;
                    *(u32x4*)(XB + off + bj * 128) = pack8(v0, v1);
                    ss += ((v0[0] * v0[0] + v0[1] * v0[1]) + (v0[2] * v0[2] + v0[3] * v0[3])) + ((v1[0] * v1[0] + v1[1] * v1[1]) + (v1[2] * v1[2] + v1[3] * v1[3]));
                }
                { const int ln_ = fq * 16 + fr; ss += shx(ss, 16, ln_); ss += shx(ss, 32, ln_); }
                if (fq == 0) ssq_out[(size_t)row * 16 + u.pn * 4 + wc] = ss;
            }
            asm volatile("" ::: "memory");
        }
    }
};
struct EpiGlu {
    static constexpr bool PERM = true, AFTER_DRAIN = false; static constexpr int HOOK_T = 0;
    unsigned char* ws;
    __device__ __forceinline__ void operator()(const f32x4 (&acc)[2][2][4][2], const Unit& u, int wr, int wc, int fr_, int fq_) const {
        int fr = fr_, fq = fq_; asm volatile("" : "+v"(fr), "+v"(fq));
        const int row0 = u.pm * 256 + wr * 64 + fr, col0 = u.pn * 128 + wc * 32 + 8 * fq;
        bf16_t* ACT = (bf16_t*)(ws + WS_ACT);
        stage_rs((const float*)(ws + WS_SSQH), u, wr, wc, fr, fq);
#pragma unroll
        for (int ai = 0; ai < 2; ++ai)
#pragma unroll
            for (int m = 0; m < 4; ++m) {
                const int row = row0 + ai * 128 + m * 16; const float rs = EPI_RSL[wr * 64 + fr + ai * 128 + m * 16];
                f32x4 o[2];
#pragma unroll
                for (int n = 0; n < 2; ++n) {
                    const f32x4 g = acc[ai][0][m][n] * rs, uu = acc[ai][1][m][n] * rs;
#pragma unroll
                    for (int j = 0; j < 4; ++j) o[n][j] = g[j] * sigm(g[j]) * uu[j];
                }
                *(u32x4*)(ACT + (size_t)row * 2816 + col0) = pack8(o[0], o[1]);
                asm volatile("" ::: "memory");
            }
    }
};
}
#define GAS __attribute__((address_space(1)))
#define LAS __attribute__((address_space(3)))
typedef unsigned short bf16;
typedef unsigned v4u __attribute__((ext_vector_type(4)));
typedef float f32x4 __attribute__((ext_vector_type(4)));
typedef short bf16x8 __attribute__((ext_vector_type(8)));
typedef GAS unsigned gu32;
typedef GAS unsigned long long gu64;
#define RLX_AGENT __ATOMIC_RELAXED, __HIP_MEMORY_SCOPE_AGENT
#define LDS_WAIT() asm volatile("s_waitcnt lgkmcnt(0)" ::: "memory")
#define VM_WAIT() asm volatile("s_waitcnt vmcnt(0)" ::: "memory")
__device__ __forceinline__ unsigned long long rt() { return __builtin_amdgcn_s_memrealtime(); }
__device__ __forceinline__ unsigned f2bf(float f) { unsigned u = __builtin_bit_cast(unsigned, f); return (u + 0x7fffu + ((u >> 16) & 1u)) >> 16; }
__device__ __forceinline__ unsigned pk2(float lo, float hi) { return f2bf(lo) | (f2bf(hi) << 16); }

#define XB_TMO      128
#define XB_XCNT(j)  (256  + 64 * (j))
#define XB_XSUB(j)  (1280 + 64 * (j))
#define XB_XGEN(j)  (2304 + 64 * (j))
#define XB_TOP      3328
#define XB_TOPGEN   3392
#define XCD_BAR_WORDS 3456
#define XB_SPIN_CAP (1u << 18)

__device__ __forceinline__ unsigned xb_ld(unsigned* p)              { return __hip_atomic_load(p, __ATOMIC_RELAXED, __HIP_MEMORY_SCOPE_AGENT); }
__device__ __forceinline__ unsigned xb_add(unsigned* p, unsigned v) { return __hip_atomic_fetch_add(p, v, __ATOMIC_RELAXED, __HIP_MEMORY_SCOPE_AGENT); }
__device__ __forceinline__ unsigned xb_xcc_id() { return (unsigned)__builtin_amdgcn_s_getreg((3 << 11) | 20) & 0xFu; }
#define XB_SPIN(cond, bar) do { unsigned _sp = 0; while (cond) { __builtin_amdgcn_s_sleep(1); \
    if ((++_sp & 255u) == 0u) { if (xb_ld(&(bar)[XB_TMO])) break; if (_sp > XB_SPIN_CAP) { atomicAdd(&(bar)[XB_TMO], 1u); break; } } } } while (0)

struct XcdBarrier {
    unsigned* bar; unsigned x;
    volatile LAS unsigned* st;
};

__device__ __forceinline__ XcdBarrier xcd_barrier_post(unsigned* bar, volatile LAS unsigned* st) {
    XcdBarrier b; b.bar = bar; b.x = xb_xcc_id(); b.st = st;
    if (threadIdx.x == 0) (void)xb_add(&bar[XB_XCNT(b.x)], 1u);
    return b;
}
__device__ __forceinline__ void xcd_barrier_complete(unsigned* bar, unsigned x, unsigned& nloc, unsigned& nx) {
    const unsigned G = gridDim.x * gridDim.y * gridDim.z;
    unsigned sum, cnt, mine, sp = 0u;
    for (;;) {
        sum = 0u; cnt = 0u; mine = 0u;
#pragma unroll
        for (unsigned j = 0; j < 16; ++j) { const unsigned c = xb_ld(&bar[XB_XCNT(j)]); sum += c; cnt += (c > 0u) ? 1u : 0u; mine = (j == x) ? c : mine; }
        if (sum == G) break;
        __builtin_amdgcn_s_sleep(1);
        if ((++sp & 255u) == 0u) { if (xb_ld(&bar[XB_TMO])) break; if (sp > XB_SPIN_CAP) { atomicAdd(&bar[XB_TMO], 1u); break; } }
    }
    nloc = mine > 0u ? mine : 1u; nx = cnt > 0u ? cnt : 1u;
}

__device__ __forceinline__ void xcd_barrier(const XcdBarrier& b) {
    asm volatile("s_waitcnt vmcnt(0)" ::: "memory");
    __syncthreads();
    if (threadIdx.x == 0) {
        unsigned* bar = b.bar;
        __builtin_amdgcn_s_waitcnt(0);
        unsigned nloc = b.st[0], nx = b.st[1];
        if (nloc == 0u) { xcd_barrier_complete(bar, b.x, nloc, nx); b.st[0] = nloc; b.st[1] = nx; }
        const unsigned old = xb_add(&bar[XB_XSUB(b.x)], 1u);
        const unsigned gen = old / nloc;
        if (old + 1u == (gen + 1u) * nloc) {
            __builtin_amdgcn_fence(__ATOMIC_RELEASE, "agent");
            asm volatile("s_waitcnt vmcnt(0)" ::: "memory");
            const unsigned og = xb_add(&bar[XB_TOP], 1u);
            const unsigned tg = og / nx;
            if (og + 1u == (tg + 1u) * nx) xb_add(&bar[XB_TOPGEN], 1u);
            else XB_SPIN(xb_ld(&bar[XB_TOPGEN]) == tg, bar);
            __builtin_amdgcn_fence(__ATOMIC_ACQUIRE, "agent");
            xb_add(&bar[XB_XGEN(b.x)], 1u);
            asm volatile("s_waitcnt vmcnt(0)" ::: "memory");
        } else {
            XB_SPIN(xb_ld(&bar[XB_XGEN(b.x)]) == gen, bar);
            __builtin_amdgcn_fence(__ATOMIC_ACQUIRE, "agent");
            asm volatile("s_waitcnt vmcnt(0)" ::: "memory");
        }
    }
    __syncthreads();
}

struct Args { const float* in[24]; float* out; unsigned char* ws; int ph_lo, ph_hi, li, pad; };
typedef const __attribute__((address_space(4))) Args* KArgs;
struct Frame { LAS unsigned char* lds; volatile LAS unsigned* MISC; gu32* ctl; int tid, lane, wave, vcu, G; unsigned char* ws; float* out; unsigned long long pr_sub; };

__device__ __forceinline__ float wave_sum(float v, int lane) {
#pragma unroll
    for (int o = 1; o < 64; o <<= 1) v += shx(v, o, lane);
    return v;
}
__device__ __forceinline__ float bf2f(unsigned short b) { return __uint_as_float((unsigned)b << 16); }
__device__ __forceinline__ float sigm(float x) { return __builtin_amdgcn_rcpf(1.0f + __expf(-x)); }

typedef float f32x2_t __attribute__((ext_vector_type(2))); typedef __bf16 bf16x2_t __attribute__((ext_vector_type(2)));
__device__ __forceinline__ unsigned cvtpk(float lo, float hi) { const f32x2_t v = {lo, hi}; const bf16x2_t b = __builtin_convertvector(v, bf16x2_t); return __builtin_bit_cast(unsigned, b); }
struct WItem { const float* W; const float* g; bf16* WT; int ldw, K, nd0, sc0, nv, k0, ldt, kofs; };
__device__ __forceinline__ void wconv_load(const WItem& t, f32x4 (&v)[16], float (&gv)[16], int lane) {
    const int c4 = (lane & 15) * 4, rk = lane >> 4; const float* gp = t.g ? t.g : t.W;
#pragma unroll
    for (int i = 0; i < 16; ++i) { const int kk = 4 * i + rk; v[i] = __builtin_nontemporal_load((const f32x4*)(t.W + (size_t)(t.k0 + kk) * t.ldw + t.sc0 + c4)); gv[i] = gp[t.k0 + kk]; }
}
__device__ __forceinline__ void wconv_store(const WItem& t, const f32x4 (&v)[16], const float (&gv)[16], LAS float* scr, int lane) {
    const int c4 = (lane & 15) * 4, rk = lane >> 4; const float vm = (c4 < t.nv) ? 1.0f : 0.0f;
#pragma unroll
    for (int i = 0; i < 16; ++i) { const float gg = t.g ? gv[i] * vm : vm; LAS float* d = scr + (4 * i + rk) * 65 + c4; d[0] = v[i][0] * gg; d[1] = v[i][1] * gg; d[2] = v[i][2] * gg; d[3] = v[i][3] * gg; }
    LDS_WAIT(); asm volatile("" ::: "memory");
    const int c = lane & 7;
#pragma unroll
    for (int jj = 0; jj < 8; ++jj) { const int n = (lane >> 3) + 8 * jj; const LAS float* s = scr + (8 * c) * 65 + n;
        v4u o; o.x = cvtpk(s[0 * 65], s[1 * 65]); o.y = cvtpk(s[2 * 65], s[3 * 65]); o.z = cvtpk(s[4 * 65], s[5 * 65]); o.w = cvtpk(s[6 * 65], s[7 * 65]);
        *(GAS v4u*)(t.WT + (size_t)(t.nd0 + n) * t.ldt + t.kofs + t.k0 + 8 * c) = o; }
    LDS_WAIT(); asm volatile("" ::: "memory");
}
__device__ __forceinline__ WItem wconv_decode(Frame& F, KArgs a, int l, int it) {
    constexpr int I_IN = 16 * 88, I_GU = 16 * 88, I_ATT = 8 * 16, I_SSD = 16 * 16, I_OUT = 16 * 16;
    int r = it; WItem t; t.g = nullptr; t.nv = 64; t.kofs = 0;
    if (r < I_IN) { const int nd0 = (r % 88) * 64; t.k0 = (r / 88) * 64; t.nd0 = nd0; t.sc0 = 0;
        if (nd0 < 3328) t.sc0 = nd0; else if (nd0 < 5376) t.sc0 = nd0 + 16; else if (nd0 == 5376) { t.sc0 = 3328; t.nv = 16; } else t.nv = 0;
        t.W = a->in[8] + (size_t)l * 1024 * 5392; t.ldw = 5392; t.K = 1024; t.WT = (bf16*)(F.ws + WS_WIN); t.g = a->in[7] + l * 1024; }
    else if ((r -= I_IN) < I_GU) { const int nd0 = (r % 88) * 64, tt = nd0 >> 8, jj = nd0 & 255; t.k0 = (r / 88) * 64; t.nd0 = nd0; t.sc0 = 128 * tt + (jj & 127);
        t.W = (jj < 128 ? a->in[20] : a->in[21]) + (size_t)l * 1024 * 2816; t.ldw = 2816; t.K = 1024; t.WT = (bf16*)(F.ws + WS_WGU); t.g = a->in[19] + l * 1024; }
    else if ((r -= I_GU) < I_ATT) { t.k0 = (r / 16) * 64; t.nd0 = t.sc0 = (r % 16) * 64; t.W = a->in[16] + (size_t)l * 512 * 1024; t.ldw = 1024; t.K = 512; t.WT = (bf16*)(F.ws + WS_WATT); t.ldt = 1536; return t; }
    else if ((r -= I_ATT) < I_SSD) { t.k0 = (r / 16) * 64; t.nd0 = t.sc0 = (r % 16) * 64; t.W = a->in[17] + (size_t)l * 1024 * 1024; t.ldw = 1024; t.K = 1024; t.WT = (bf16*)(F.ws + WS_WATT); t.ldt = 1536; t.kofs = 512; t.g = a->in[14] + l * 1024; return t; }
    else if ((r -= I_SSD) < I_OUT) { t.k0 = (r / 16) * 64; t.nd0 = t.sc0 = (r % 16) * 64; t.W = a->in[18] + (size_t)l * 1024 * 1024; t.ldw = 1024; t.K = 1024; t.WT = (bf16*)(F.ws + WS_WOUT); }
    else { r -= I_OUT; t.k0 = (r / 16) * 64; t.nd0 = t.sc0 = (r % 16) * 64; t.W = a->in[22] + (size_t)l * 2816 * 1024; t.ldw = 1024; t.K = 2816; t.WT = (bf16*)(F.ws + WS_WDN); }
    t.ldt = t.K; return t;
}
__device__ __forceinline__ void p0_convert(Frame& F, KArgs a, int l) {
    LAS float* scr = (LAS float*)(F.lds + F.wave * 16896);
    const int gw = F.vcu * NWAVES + F.wave, NGW = F.G * NWAVES;
    constexpr int NITEMS = MK_SPLIT ? 16 * 88 * 2 + 8 * 16 + 16 * 16 * 2 + 44 * 16 : 16 * 88;
    {
        f32x4 va[16], vb[16]; float ga[16], gb[16];
        int it = gw; WItem ta, tb_;
        if (it < NITEMS) { ta = wconv_decode(F, a, l, it); wconv_load(ta, va, ga, F.lane); }
        while (it < NITEMS) {
            const int it2 = it + NGW, it3 = it2 + NGW;
            if (it2 < NITEMS) { tb_ = wconv_decode(F, a, l, it2); wconv_load(tb_, vb, gb, F.lane); }
            wconv_store(ta, va, ga, scr, F.lane);
            if (it2 >= NITEMS) break;
            if (it3 < NITEMS) { ta = wconv_decode(F, a, l, it3); wconv_load(ta, va, ga, F.lane); }
            wconv_store(tb_, vb, gb, scr, F.lane);
            it = it3;
        }
    }
    if (l == 0) {
        bf16* XB = (bf16*)(F.ws + WS_XB); float* SSQX = (float*)(F.ws + WS_SSQX);
        for (int m0 = 2 * gw; m0 < MALL; m0 += 2 * NGW) {
            f32x4 v[2][4];
#pragma unroll
            for (int q = 0; q < 2; ++q) { const int m = m0 + q; const float* xrow = m < MP ? a->in[0] + (size_t)m * DM : a->in[1] + (size_t)(m - MP) * DM;
                const GAS f32x4* xr = (const GAS f32x4*)xrow + F.lane;
#pragma unroll
                for (int j = 0; j < 4; ++j) v[q][j] = __builtin_nontemporal_load((const f32x4*)(xrow) + F.lane + 64 * j); }
#pragma unroll
            for (int q = 0; q < 2; ++q) { const int m = m0 + q; float s = 0.f;
#pragma unroll
                for (int j = 0; j < 4; ++j) s += (v[q][j].x * v[q][j].x + v[q][j].y * v[q][j].y) + (v[q][j].z * v[q][j].z + v[q][j].w * v[q][j].w);
                s = wave_sum(s, F.lane);
                GAS unsigned long long* o8 = (GAS unsigned long long*)(XB + (size_t)m * DM) + F.lane;
#pragma unroll
                for (int j = 0; j < 4; ++j) o8[64 * j] = (unsigned long long)cvtpk(v[q][j].x, v[q][j].y) | ((unsigned long long)cvtpk(v[q][j].z, v[q][j].w) << 32);
                if (F.lane < 16) SSQX[(size_t)m * 16 + F.lane] = F.lane == 0 ? s : 0.f; }
        }
    }
}

template <int SUB>
__device__ __forceinline__ void p0_convert_slack(Frame& F, KArgs a, int l) {
    if ((int)blockIdx.x < 150) return;
    LAS float* scr = (LAS float*)(F.lds + F.wave * 16896);
    const int gw = ((int)blockIdx.x - 150) * NWAVES + F.wave, NGW = 106 * NWAVES;
    constexpr int I_IN = 16 * 88, I_GU = 16 * 88, I_ATT = 8 * 16, I_SSD = 16 * 16, I_OUT = 16 * 16, I_DN = 44 * 16;
    constexpr int NSUB = SUB == 0 ? I_IN + I_ATT + I_SSD + I_OUT : (SUB == 1 ? I_GU + I_DN : I_GU + I_ATT + I_SSD + I_OUT + I_DN);
#define P0S_MAP(s) (SUB == 0 ? ((s) < I_IN ? (s) : (s) + I_GU) : (SUB == 1 ? ((s) < I_GU ? (s) + I_IN : (s) + I_IN + I_ATT + I_SSD + I_OUT) : (s) + I_IN))
    f32x4 va[16], vb[16]; float ga[16], gb[16];
    int it = gw; WItem ta, tb_;
    if (it < NSUB) { ta = wconv_decode(F, a, l, P0S_MAP(it)); wconv_load(ta, va, ga, F.lane); }
    while (it < NSUB) {
        const int it2 = it + NGW, it3 = it2 + NGW;
        if (it2 < NSUB) { tb_ = wconv_decode(F, a, l, P0S_MAP(it2)); wconv_load(tb_, vb, gb, F.lane); }
        wconv_store(ta, va, ga, scr, F.lane);
        if (it2 >= NSUB) break;
        if (it3 < NSUB) { ta = wconv_decode(F, a, l, P0S_MAP(it3)); wconv_load(ta, va, ga, F.lane); }
        wconv_store(tb_, vb, gb, scr, F.lane);
        it = it3;
    }
#undef P0S_MAP
}

typedef LAS unsigned short lbf;
typedef short v4i16_t __attribute__((ext_vector_type(4)));
__device__ __forceinline__ bf16x8 ldfrag(const lbf* base, int row, int ld, int k0, int lane) { return *(const LAS bf16x8*)(base + row * ld + k0 + 8 * (lane >> 4)); }
__device__ __forceinline__ bf16x8 ldfrag_tr(const lbf* M, int ld, int k0, int c0, int lane) {
    const int i16 = lane & 15;
    const lbf* p0 = M + (k0 + 8 * (lane >> 4) + (i16 >> 2)) * ld + c0 + 4 * (i16 & 3);
    const v4i16_t lo = __builtin_amdgcn_ds_read_tr16_b64_v4i16((LAS v4i16_t*)p0);
    const v4i16_t hi = __builtin_amdgcn_ds_read_tr16_b64_v4i16((LAS v4i16_t*)(p0 + 4 * ld));
    return (bf16x8){lo[0], lo[1], lo[2], lo[3], hi[0], hi[1], hi[2], hi[3]};
}
#define WG_BAR() do { asm volatile("s_waitcnt lgkmcnt(0)" ::: "memory"); __builtin_amdgcn_s_barrier(); asm volatile("" ::: "memory"); } while (0)
template <int CTRL> __device__ __forceinline__ float dppf(float v) { return __int_as_float(__builtin_amdgcn_update_dpp(0, __float_as_int(v), CTRL, 0xf, 0xf, true)); }
__device__ __forceinline__ float row16_sum(float s) { s += dppf<0xB1>(s); s += dppf<0x4E>(s); s += dppf<0x141>(s); s += dppf<0x140>(s); return s; }
#define MFMA16(a, b, c) __builtin_amdgcn_mfma_f32_16x16x32_bf16((a), (b), (c), 0, 0, 0)
#define FRAME_REOPAQUE(F) do { int tv_ = threadIdx.x; asm volatile("" : "+v"(tv_)); (F).tid = tv_; (F).lane = tv_ & 63; (F).wave = __builtin_amdgcn_readfirstlane(tv_ >> 6); } while (0)
__device__ __forceinline__ int t5_bucket(int rel) {
    const int n = rel < 0 ? -rel : rel;
    const int big = 8 + (n >= 12) + (n >= 16) + (n >= 23) + (n >= 32) + (n >= 46) + (n >= 64) + (n >= 91);
    return (rel > 0 ? 16 : 0) + (n < 8 ? n : big);
}
__device__ __forceinline__ void unpk8(const v4u w, float (&d)[8]) {
    d[0] = __uint_as_float(w.x << 16); d[1] = __uint_as_float(w.x & 0xffff0000u); d[2] = __uint_as_float(w.y << 16); d[3] = __uint_as_float(w.y & 0xffff0000u);
    d[4] = __uint_as_float(w.z << 16); d[5] = __uint_as_float(w.z & 0xffff0000u); d[6] = __uint_as_float(w.w << 16); d[7] = __uint_as_float(w.w & 0xffff0000u);
}
constexpr int AT_KS = 0, AT_KLD = 72, AT_V = 27648, AT_VLD = 80, AT_P = 58368, AT_PLD = 200, AT_TB = 109568;
__device__ __forceinline__ void attn_tables(Frame& F, KArgs a) {
    LAS float* tb = (LAS float*)(F.lds + AT_TB);
    for (int e = F.tid; e < 2048; e += 512) { const int gg = e >> 10, r = (e >> 8) & 3, rel = (e & 255) - 192; tb[e] = a->in[6][t5_bucket(rel) * 8 + gg * 4 + r] * 1.4426950408889634f; }
    __syncthreads();
}
template <bool SAMPLE>
__device__ __forceinline__ void attn_unit(Frame& F, KArgs a, int l, int b, int c, int g) {
    lbf* Ks = (lbf*)(F.lds + AT_KS); lbf* Vs = (lbf*)(F.lds + AT_V); lbf* Pw = (lbf*)(F.lds + AT_P) + F.wave * (16 * AT_PLD); const LAS float* tb = (const LAS float*)(F.lds + AT_TB) + g * 1024;
    bf16* Qb = (bf16*)(F.ws + WS_Q); const bf16* KVb = (const bf16*)(F.ws + WS_KV);
    const int tid = F.tid, lane = F.lane, wave = F.wave;
    const int rowbase = SAMPLE ? MP + b * 16 : b * 4096 + c * 64;
    const int npass = SAMPLE ? (wave < 4 ? 1 : 0) : 2;
    const int r = SAMPLE ? (wave & 3) : (wave >> 1);
    const int q4 = lane >> 4, fr = lane & 15;
    bf16x8 qfa[2][2];
#pragma unroll
    for (int ps = 0; ps < 2; ++ps) { const int i0 = SAMPLE ? 0 : (wave & 1) * 32 + ps * 16; const size_t qoff = (size_t)(rowbase + i0 + fr) * OY_LD + (g * 4 + r) * 64;
        qfa[ps][0] = *(const bf16x8*)(Qb + qoff + 8 * q4); qfa[ps][1] = *(const bf16x8*)(Qb + qoff + 32 + 8 * q4); }
    for (int e = tid; e < 1536; e += 512) {
        const int key = e >> 3, pc = e & 7;
        v4u kp = (v4u){0u, 0u, 0u, 0u}, vp = (v4u){0u, 0u, 0u, 0u}; float kf[8], vf[8]; bool valid, exact = false;
        if (SAMPLE) {
            valid = key < 144;
            if (key < 128) { exact = true;
                const size_t off = (((size_t)(l * 16 + b) * 128 + key) * 2 + g) * 64 + pc * 8;
                const f32x4 k0 = *(const f32x4*)(a->in[2] + off), k1 = *(const f32x4*)(a->in[2] + off + 4), v0 = *(const f32x4*)(a->in[3] + off), v1 = *(const f32x4*)(a->in[3] + off + 4);
#pragma unroll
                for (int j = 0; j < 4; ++j) { kf[j] = k0[j]; kf[4 + j] = k1[j]; vf[j] = v0[j]; vf[4 + j] = v1[j]; }
                kp.x = cvtpk(kf[0], kf[1]); kp.y = cvtpk(kf[2], kf[3]); kp.z = cvtpk(kf[4], kf[5]); kp.w = cvtpk(kf[6], kf[7]);
                vp.x = cvtpk(vf[0], vf[1]); vp.y = cvtpk(vf[2], vf[3]); vp.z = cvtpk(vf[4], vf[5]); vp.w = cvtpk(vf[6], vf[7]);
            }
        } else valid = (c - 2) * 64 + key >= 0;
        if (SAMPLE) { if (valid && !exact) { const size_t row = (size_t)(MP + b * 16 + key - 128);
                kp = *(const v4u*)(KVb + row * 256 + g * 64 + pc * 8); vp = *(const v4u*)(KVb + row * 256 + 128 + g * 64 + pc * 8); } }
        else { const int pos = (c - 2) * 64 + key; const size_t row = (size_t)(b * 4096 + (pos < 0 ? 0 : pos)); const unsigned k_ = valid ? 0xffffffffu : 0u;
            const v4u k0_ = *(const v4u*)(KVb + row * 256 + g * 64 + pc * 8), v0_ = *(const v4u*)(KVb + row * 256 + 128 + g * 64 + pc * 8);
            kp = (v4u){k0_.x & k_, k0_.y & k_, k0_.z & k_, k0_.w & k_}; vp = (v4u){v0_.x & k_, v0_.y & k_, v0_.z & k_, v0_.w & k_}; }
        *(LAS v4u*)(Ks + key * AT_KLD + pc * 8) = kp; *(LAS v4u*)(Vs + key * AT_VLD + pc * 8) = vp;
        float* ko = nullptr; float* vo = nullptr;
        if (SAMPLE) { if (key >= 16 && key < 144) { const size_t o = (((size_t)(l * 16 + b) * 128 + key - 16) * 2 + g) * 64 + pc * 8; ko = F.out + O_KS + o; vo = F.out + O_VS + o; } }
        else if (c >= 62 && key >= 128) { const size_t o = (((size_t)(l * 4 + b) * 128 + (c - 62) * 64 + key - 128) * 2 + g) * 64 + pc * 8; ko = F.out + O_KP + o; vo = F.out + O_VP + o; }
        if (ko) { if (!exact) { unpk8(kp, kf); unpk8(vp, vf); }
                  *(f32x4*)ko = (f32x4){kf[0], kf[1], kf[2], kf[3]}; *(f32x4*)(ko + 4) = (f32x4){kf[4], kf[5], kf[6], kf[7]};
                  *(f32x4*)vo = (f32x4){vf[0], vf[1], vf[2], vf[3]}; *(f32x4*)(vo + 4) = (f32x4){vf[4], vf[5], vf[6], vf[7]}; }
    }
    WG_BAR();
    const float sink = a->in[15][l * 8 + g * 4 + r] * 1.4426950408889634f;
#pragma unroll
    for (int ps = 0; ps < 2; ++ps) { if (ps >= npass) break;
        const int i0 = SAMPLE ? 0 : (wave & 1) * 32 + ps * 16;
        const bf16x8 qf0 = qfa[ps][0], qf1 = qfa[ps][1];
        f32x4 s[12];
#pragma unroll
        for (int hf = 0; hf < 2; ++hf) {
            bf16x8 kfr[6][2];
#pragma unroll
            for (int kk = 0; kk < 6; ++kk) { kfr[kk][0] = ldfrag(Ks, 16 * (6 * hf + kk) + fr, AT_KLD, 0, lane); kfr[kk][1] = ldfrag(Ks, 16 * (6 * hf + kk) + fr, AT_KLD, 32, lane); }
            asm volatile("" ::: "memory");
#pragma unroll
            for (int kk = 0; kk < 6; ++kk) { const int kt = 6 * hf + kk; s[kt] = (f32x4){0.f, 0.f, 0.f, 0.f};
                s[kt] = MFMA16(kfr[kk][0], qf0, s[kt]); s[kt] = MFMA16(kfr[kk][1], qf1, s[kt]); }
        }
        const int jlo = SAMPLE ? 0 : (c >= 2 ? 0 : (2 - c) * 64), jhi = SAMPLE ? 144 : 192;
        float mx = -3.0e38f; float bz[12][4];
#pragma unroll
        for (int kt = 0; kt < 12; ++kt)
#pragma unroll
            for (int ii = 0; ii < 4; ++ii) bz[kt][ii] = tb[r * 256 + 16 * kt + 4 * q4 + ii - (i0 + fr) + 64];
        asm volatile("" ::: "memory");
#pragma unroll
        for (int kt = 0; kt < 12; ++kt)
#pragma unroll
            for (int ii = 0; ii < 4; ++ii) s[kt][ii] = s[kt][ii] * 0.18033688011112042f + bz[kt][ii];
        if (SAMPLE || jlo > 0) {
#pragma unroll
            for (int kt = 0; kt < 12; ++kt)
#pragma unroll
                for (int ii = 0; ii < 4; ++ii) { const int key = 16 * kt + 4 * q4 + ii; s[kt][ii] = (key >= jlo && key < jhi) ? s[kt][ii] : -1.0e30f; }
        }
#pragma unroll
        for (int kt = 0; kt < 12; ++kt) mx = fmaxf(mx, fmaxf(fmaxf(s[kt][0], s[kt][1]), fmaxf(s[kt][2], s[kt][3])));
        mx = fmaxf(mx, shx(mx, 16, lane)); mx = fmaxf(mx, shx(mx, 32, lane)); mx = fmaxf(mx, sink);
        float sum = 0.f;
#pragma unroll
        for (int kt = 0; kt < 12; ++kt)
#pragma unroll
            for (int ii = 0; ii < 4; ++ii) { const float p = __builtin_amdgcn_exp2f(s[kt][ii] - mx); s[kt][ii] = p; sum += p; }
        sum += shx(sum, 16, lane); sum += shx(sum, 32, lane);
        const float inv = 1.0f / (sum + __builtin_amdgcn_exp2f(sink - mx));
#pragma unroll
        for (int kt = 0; kt < 12; ++kt) {
            const unsigned long long w = (unsigned long long)cvtpk(s[kt][0], s[kt][1]) | ((unsigned long long)cvtpk(s[kt][2], s[kt][3]) << 32);
            *(LAS unsigned long long*)(Pw + fr * AT_PLD + 16 * kt + 4 * q4) = w; }
        LDS_WAIT(); asm volatile("" ::: "memory");
        f32x4 o[4];
#pragma unroll
        for (int dt = 0; dt < 4; ++dt) o[dt] = (f32x4){0.f, 0.f, 0.f, 0.f};
#pragma unroll
        for (int k2 = 0; k2 < 3; ++k2) {
            bf16x8 pa[2], vf[2][4];
#pragma unroll
            for (int kq = 0; kq < 2; ++kq) { pa[kq] = ldfrag(Pw, fr, AT_PLD, (2 * k2 + kq) * 32, lane);
#pragma unroll
                for (int dt = 0; dt < 4; ++dt) vf[kq][dt] = ldfrag_tr(Vs, AT_VLD, (2 * k2 + kq) * 32, 16 * dt, lane); }
            asm volatile("" ::: "memory");
#pragma unroll
            for (int kq = 0; kq < 2; ++kq)
#pragma unroll
                for (int dt = 0; dt < 4; ++dt) o[dt] = MFMA16(pa[kq], vf[kq][dt], o[dt]);
        }
        asm volatile("" ::: "memory");
        { float iq[4];
#pragma unroll
          for (int ii = 0; ii < 4; ++ii) iq[ii] = bperm_f(inv, 4 * q4 + ii);
#pragma unroll
          for (int dt = 0; dt < 4; ++dt)
#pragma unroll
            for (int ii = 0; ii < 4; ++ii) Pw[(4 * q4 + ii) * AT_KLD + 16 * dt + fr] = (unsigned short)(cvtpk(o[dt][ii] * iq[ii], 0.f) & 0xffffu); }
        LDS_WAIT(); asm volatile("" ::: "memory");
        { const int orow = lane >> 2, och = (lane & 3) * 16;
          const v4u w0 = *(const LAS v4u*)(Pw + orow * AT_KLD + och), w1 = *(const LAS v4u*)(Pw + orow * AT_KLD + och + 8);
          bf16* op = Qb + (size_t)(rowbase + i0 + orow) * OY_LD + (g * 4 + r) * 64 + och;
          *(v4u*)op = w0; *(v4u*)(op + 8) = w1; }
        LDS_WAIT(); asm volatile("" ::: "memory");
    }
    WG_BAR();
}

constexpr int S2_CM = 0, S2_BM = 17408, S2_X = 34816, S2_XS = 55296, S2_GM = 75776, S2_HB = 94208, S2_SC = 129024;
constexpr int S2_LDN = 136, S2_LDX = 80, S2_LDG = 72, S2_XH = 64 * 80, S2_GH = 64 * 72, S2_HH = 64 * 136;
constexpr int NSEG = 8, SEGCH = 8;
__device__ __forceinline__ void unpk4(unsigned long long w, float (&d)[4]) {
    d[0] = __uint_as_float((unsigned)w << 16); d[1] = __uint_as_float((unsigned)w & 0xffff0000u); d[2] = __uint_as_float((unsigned)(w >> 32) << 16); d[3] = __uint_as_float((unsigned)(w >> 32) & 0xffff0000u);
}
template <int MODE>
__device__ __forceinline__ void ssd_unit(Frame& F, KArgs a, int l, int b, int hp, int seg) {
    constexpr bool SAMPLE = MODE == 2, FULL = MODE != 1;
    lbf* Cm = (lbf*)(F.lds + S2_CM); lbf* Bm = (lbf*)(F.lds + S2_BM); lbf* Xm = (lbf*)(F.lds + S2_X); lbf* Xs = (lbf*)(F.lds + S2_XS);
    lbf* Gm = (lbf*)(F.lds + S2_GM); lbf* Hb = (lbf*)(F.lds + S2_HB); LAS float* scb = (LAS float*)(F.lds + S2_SC);
    const int tid = F.tid, lane = F.lane, wave = F.wave, q4 = lane >> 4, fr = lane & 15, g = hp >> 2, hh = wave >> 2, w4 = wave & 3, h = 2 * hp + hh;
    const bf16* XBC = (const bf16*)(F.ws + WS_XBC); bf16* Zb = (bf16*)(F.ws + WS_Q) + OY_Z;     const float* DT = (const float*)(F.ws + WS_DT); float* SSQY = (float*)(F.ws + WS_SSQY);
    float* SEGE = F.out; float* SEGD = (float*)(F.ws + WS_SEGD);
    const float a_h = -__expf(a->in[12][l * 16 + h]);
    const int L = SAMPLE ? 16 : 64, nchunk = SAMPLE ? 1 : SEGCH, c0 = SAMPLE ? 0 : seg * SEGCH;
    const int uh = (b * 16 + h) * (NSEG - 1);
    f32x4 hacc[8];
#pragma unroll
    for (int j = 0; j < 8; ++j) {
#pragma unroll
        for (int i = 0; i < 4; ++i) hacc[j][i] = SAMPLE ? a->in[5][(((size_t)(l * 16 + b) * 16 + h) * 64 + 16 * w4 + fr) * 128 + 16 * j + 4 * q4 + i] : 0.f;
    }
    constexpr int NPR = FULL ? 48 : 32, NPC = FULL ? 6 : 4;
    const bf16* CX = (const bf16*)((const unsigned char*)F.out + OUT_CX_BYTES);
    v4u tp[NPC];
#define SSD_PREFETCH(r0_) do { _Pragma("unroll") for (int i = 0; i < NPC; ++i) { const int q_ = tid + 512 * i, row_ = q_ / NPR, pc_ = q_ % NPR; \
        const int col_ = pc_ < 16 ? (2 * hp) * 64 + pc_ * 8 : (pc_ < 32 ? 1024 + g * 128 + (pc_ - 16) * 8 : 1280 + g * 128 + (pc_ - 32) * 8); \
        tp[i] = *(const v4u*)(CX + (size_t)((r0_) + (SAMPLE ? (row_ & 15) : row_)) * 1536 + col_); } } while (0)
    float dtv = 0.f;
    if (SAMPLE) { SSD_PREFETCH(MP + b * 16); if (w4 == 0) { const float d_ = DT[(size_t)(MP + b * 16 + (lane & 15)) * 16 + h]; dtv = lane < 16 ? d_ : 0.f; } }
    else { SSD_PREFETCH(b * 4096 + c0 * 64); if (w4 == 0) dtv = DT[(size_t)(b * 4096 + c0 * 64 + lane) * 16 + h]; }
    if (MODE == 0) {
        const unsigned long long* Eb = (const unsigned long long*)SEGE + (size_t)uh * 2048 + (w4 * 8) * 64 + lane;
        unsigned long long ea[8], eb[8];
        if (seg > 0) {
#pragma unroll
            for (int j = 0; j < 8; ++j) ea[j] = Eb[j * 64];
        }
        for (int s2 = 0; s2 < seg; s2 += 2) {
            const bool two = s2 + 1 < seg;
            if (two) {
#pragma unroll
                for (int j = 0; j < 8; ++j) eb[j] = Eb[(s2 + 1) * 2048 + j * 64];
            }
            { const float dec = __expf(SEGD[uh + s2]);
#pragma unroll
              for (int j = 0; j < 8; ++j) { float e4[4]; unpk4(ea[j], e4); hacc[j] = hacc[j] * dec + (f32x4){e4[0], e4[1], e4[2], e4[3]}; } }
            if (s2 + 2 < seg) {
#pragma unroll
                for (int j = 0; j < 8; ++j) ea[j] = Eb[(s2 + 2) * 2048 + j * 64];
            }
            if (two) { const float dec = __expf(SEGD[uh + s2 + 1]);
#pragma unroll
              for (int j = 0; j < 8; ++j) { float e4[4]; unpk4(eb[j], e4); hacc[j] = hacc[j] * dec + (f32x4){e4[0], e4[1], e4[2], e4[3]}; } }
        }
    }
#define SSD_MIRROR() do { _Pragma("unroll") for (int j = 0; j < 8; ++j) \
        *(LAS unsigned long long*)(Hb + hh * S2_HH + (16 * w4 + fr) * S2_LDN + 16 * j + 4 * q4) = (unsigned long long)cvtpk(hacc[j][0], hacc[j][1]) | ((unsigned long long)cvtpk(hacc[j][2], hacc[j][3]) << 32); } while (0)
    if (FULL) SSD_MIRROR();
    float segsum = 0.f;
    const float D0 = a->in[13][l * 16 + 2 * hp], D1 = a->in[13][l * 16 + 2 * hp + 1];
#define SSD_SCAN(buf) do { float ac = dtv * a_h; _Pragma("unroll") for (int o = 1; o < 64; o <<= 1) { const float t = bperm_f(ac, lane >= o ? lane - o : lane); if (lane >= o) ac += t; } \
        const float tot = bperm_f(ac, 63); segsum += tot; LAS float* sc__ = scb + (hh * 2 + (buf)) * 192; sc__[lane] = dtv; sc__[64 + lane] = ac; sc__[128 + lane] = dtv * __expf(tot - ac); } while (0)
    if (w4 == 0) SSD_SCAN(0);
    WG_BAR();
    for (int cc = 0; cc < nchunk; ++cc) {
        const int c = c0 + cc, cur = cc & 1;
        const int r0 = SAMPLE ? MP + b * 16 : b * 4096 + c * 64;
        const LAS float* sc0 = scb + cur * 192; const LAS float* sc1 = scb + (2 + cur) * 192; const LAS float* scm = hh ? sc1 : sc0;
        unsigned short zv[4][4];
#pragma unroll
        for (int pt = 0; pt < 4; ++pt)
#pragma unroll
            for (int i = 0; i < 4; ++i) { const int lidx = 16 * w4 + 4 * q4 + i; zv[pt][i] = Zb[(size_t)(r0 + (SAMPLE ? (lidx & 15) : lidx)) * OY_LD + h * 64 + 16 * pt + fr]; }
        if (FULL && cc > 0) SSD_MIRROR();
#pragma unroll
        for (int i = 0; i < NPC; ++i) { const int q_ = tid + 512 * i, row_ = q_ / NPR, pc_ = q_ % NPR;
            if (SAMPLE && row_ >= 16) tp[i] = (v4u){0u, 0u, 0u, 0u};
            if (pc_ < 16) { const int hc = pc_ >> 3, p0 = (pc_ & 7) * 8; const float wl = (hc ? sc1 : sc0)[128 + row_];
                if (FULL) *(LAS v4u*)(Xm + hc * S2_XH + row_ * S2_LDX + p0) = tp[i];
                float xv[8]; unpk8(tp[i], xv); v4u sx; sx.x = cvtpk(xv[0] * wl, xv[1] * wl); sx.y = cvtpk(xv[2] * wl, xv[3] * wl); sx.z = cvtpk(xv[4] * wl, xv[5] * wl); sx.w = cvtpk(xv[6] * wl, xv[7] * wl);
                *(LAS v4u*)(Xs + hc * S2_XH + row_ * S2_LDX + p0) = sx; }
            else if (pc_ < 32) *(LAS v4u*)(Bm + row_ * S2_LDN + (pc_ - 16) * 8) = tp[i];
            else *(LAS v4u*)(Cm + row_ * S2_LDN + (pc_ - 32) * 8) = tp[i]; }
        if (!SAMPLE && cc + 1 < nchunk) { SSD_PREFETCH(b * 4096 + (c + 1) * 64); if (w4 == 0) dtv = DT[(size_t)(b * 4096 + (c + 1) * 64 + lane) * 16 + h]; }
        WG_BAR();
        { const float dec = __expf(scm[64 + 63]);
          const bf16x8 xa0 = ldfrag_tr(Xs + hh * S2_XH, S2_LDX, 0, 16 * w4, lane), xa1 = ldfrag_tr(Xs + hh * S2_XH, S2_LDX, 32, 16 * w4, lane);
#pragma unroll
          for (int jh = 0; jh < 2; ++jh) { bf16x8 bb[4][2];
#pragma unroll
              for (int j4 = 0; j4 < 4; ++j4) { bb[j4][0] = ldfrag_tr(Bm, S2_LDN, 0, 16 * (4 * jh + j4), lane); bb[j4][1] = ldfrag_tr(Bm, S2_LDN, 32, 16 * (4 * jh + j4), lane); }
              asm volatile("" ::: "memory");
#pragma unroll
              for (int j4 = 0; j4 < 4; ++j4) { const int j = 4 * jh + j4; hacc[j] = hacc[j] * dec; hacc[j] = MFMA16(bb[j4][0], xa0, hacc[j]); hacc[j] = MFMA16(bb[j4][1], xa1, hacc[j]); } }
        }
        if (!FULL) { if (w4 == 0 && cc + 1 < nchunk) SSD_SCAN(cur ^ 1); WG_BAR(); continue; }
        { bf16x8 ac4[4];
#pragma unroll
          for (int ks = 0; ks < 4; ++ks) ac4[ks] = ldfrag(Cm, 16 * w4 + fr, S2_LDN, 32 * ks, lane);
          lbf* Gw = Gm + hh * S2_GH + (16 * w4) * S2_LDG;
          const float Dd = hh ? D1 : D0; const int lidx = 16 * w4 + fr; const float ac_l = scm[64 + lidx];
#pragma unroll
          for (int st = 0; st < 4; ++st) {
              unsigned long long gp = 0ull;
              if (st <= w4) { bf16x8 fb[4];
#pragma unroll
                  for (int ks = 0; ks < 4; ++ks) fb[ks] = ldfrag(Bm, 16 * st + fr, S2_LDN, 32 * ks, lane);
                  asm volatile("" ::: "memory");
                  f32x4 acc = (f32x4){0.f, 0.f, 0.f, 0.f};
#pragma unroll
                  for (int ks = 0; ks < 4; ++ks) acc = MFMA16(fb[ks], ac4[ks], acc);
                  const int s0 = 16 * st + 4 * q4; const f32x4 ac_s = *(const LAS f32x4*)(scm + 64 + s0), dt_s = *(const LAS f32x4*)(scm + s0);
                  float gv[4];
#pragma unroll
                  for (int i = 0; i < 4; ++i) { gv[i] = (s0 + i <= lidx) ? acc[i] * __expf(ac_l - ac_s[i]) * dt_s[i] : 0.f; gv[i] += (s0 + i == lidx) ? Dd : 0.f; }
                  gp = (unsigned long long)cvtpk(gv[0], gv[1]) | ((unsigned long long)cvtpk(gv[2], gv[3]) << 32); }
              *(LAS unsigned long long*)(Gw + fr * S2_LDG + 16 * st + 4 * q4) = gp;
          }
          LDS_WAIT(); asm volatile("" ::: "memory");
          const bf16x8 ag0 = ldfrag(Gw, fr, S2_LDG, 0, lane), ag1 = ldfrag(Gw, fr, S2_LDG, 32, lane);
          float eac[4], sq[4];
#pragma unroll
          for (int i = 0; i < 4; ++i) { eac[i] = __expf(scm[64 + 16 * w4 + 4 * q4 + i]); sq[i] = 0.f; }
          lbf* Ys = Gm + hh * S2_GH + (16 * w4) * S2_LDG;
          f32x4 yv[4];
#pragma unroll
          for (int pt = 0; pt < 4; ++pt) {
              bf16x8 xq[2], hq[4];
              xq[0] = ldfrag_tr(Xm + hh * S2_XH, S2_LDX, 0, 16 * pt, lane); xq[1] = ldfrag_tr(Xm + hh * S2_XH, S2_LDX, 32, 16 * pt, lane);
#pragma unroll
              for (int ks = 0; ks < 4; ++ks) hq[ks] = ldfrag(Hb + hh * S2_HH, 16 * pt + fr, S2_LDN, 32 * ks, lane);
              asm volatile("" ::: "memory");
              f32x4 yd = (f32x4){0.f, 0.f, 0.f, 0.f}, yo = (f32x4){0.f, 0.f, 0.f, 0.f};
              yd = MFMA16(ag0, xq[0], yd); yd = MFMA16(ag1, xq[1], yd);
#pragma unroll
              for (int ks = 0; ks < 4; ++ks) yo = MFMA16(ac4[ks], hq[ks], yo);
#pragma unroll
              for (int i = 0; i < 4; ++i) { const float z = bf2f(zv[pt][i]); const float y = (yd[i] + eac[i] * yo[i]) * (z * sigm(z)); yv[pt][i] = y; sq[i] += y * y; }
          }
          asm volatile("" ::: "memory");
#pragma unroll
          for (int pt = 0; pt < 4; ++pt)
#pragma unroll
              for (int i = 0; i < 4; ++i) Ys[(4 * q4 + i) * S2_LDG + 16 * pt + fr] = (unsigned short)(cvtpk(yv[pt][i], 0.f) & 0xffffu);
#pragma unroll
          for (int i = 0; i < 4; ++i) { const float s = row16_sum(sq[i]);
              const int lidx = 16 * w4 + 4 * q4 + i; if (fr == 0 && lidx < L) SSQY[(size_t)(r0 + lidx) * 16 + h] = s; }
          LDS_WAIT(); asm volatile("" ::: "memory");
          { const int orow = lane >> 2, och = (lane & 3) * 16;
            const v4u y0 = *(const LAS v4u*)(Ys + orow * S2_LDG + och), y1 = *(const LAS v4u*)(Ys + orow * S2_LDG + och + 8);
            if (16 * w4 + orow < L) { bf16* yp = Zb + (size_t)(r0 + 16 * w4 + orow) * OY_LD + h * 64 + och; *(v4u*)yp = y0; *(v4u*)(yp + 8) = y1; } }
        }
        if (w4 == 0 && cc + 1 < nchunk) SSD_SCAN(cur ^ 1);
        WG_BAR();
    }
#undef SSD_PREFETCH
#undef SSD_SCAN
#undef SSD_MIRROR
    if (MODE == 1) {
#pragma unroll
        for (int j = 0; j < 8; ++j) ((unsigned long long*)SEGE)[(size_t)(uh + seg) * 2048 + (w4 * 8 + j) * 64 + lane] = (unsigned long long)cvtpk(hacc[j][0], hacc[j][1]) | ((unsigned long long)cvtpk(hacc[j][2], hacc[j][3]) << 32);
        if (w4 == 0 && lane == 0) SEGD[uh + seg] = segsum;
    } else if (SAMPLE || seg == NSEG - 1) {
        float* stout = F.out + (SAMPLE ? O_SS + ((size_t)(l * 16 + b) * 16 + h) * 8192 : O_SP + ((size_t)(l * 4 + b) * 16 + h) * 8192);
#pragma unroll
        for (int j = 0; j < 8; ++j)
#pragma unroll
            for (int i = 0; i < 4; ++i) stout[(size_t)(16 * w4 + fr) * 128 + 16 * j + 4 * q4 + i] = hacc[j][i];
    }
    WG_BAR();
}

__device__ __forceinline__ void ssd_pass1(Frame& F, KArgs a, int l, int b, int hp, int seg) {
    lbf* XsB = (lbf*)(F.lds); lbf* BmB = (lbf*)(F.lds + 40960); LAS float* wseg = (LAS float*)(F.lds + 75776); LAS float* wtot = (LAS float*)(F.lds + 79872);
    const int tid = F.tid, lane = F.lane, wave = F.wave, g = hp >> 2, hh = wave >> 2, w4 = wave & 3, h = 2 * hp + hh;
    const bf16* CX = (const bf16*)((const unsigned char*)F.out + OUT_CX_BYTES); const float* DT = (const float*)(F.ws + WS_DT);
    unsigned long long* SEGE = (unsigned long long*)F.out; float* SEGD = (float*)(F.ws + WS_SEGD);
    const int r0 = b * 4096 + seg * 512;
    v4u tpA[4], tpB[4];
#define P1_PREFETCH(tp, t_) do { _Pragma("unroll") for (int i = 0; i < 4; ++i) { const int q_ = tid + 512 * i, row_ = q_ >> 5, pc_ = q_ & 31; \
        const int col_ = pc_ < 16 ? (2 * hp) * 64 + pc_ * 8 : 1024 + g * 128 + (pc_ - 16) * 8; tp[i] = *(const v4u*)(CX + (size_t)(r0 + 64 * (t_) + row_) * 1536 + col_); } } while (0)
    P1_PREFETCH(tpA, 0); P1_PREFETCH(tpB, 1);
    {
        const int row = 64 * wave + lane; const float* dp = DT + (size_t)(r0 + row) * 16 + 2 * hp;
        const float d0 = dp[0], d1 = dp[1];
        float ac0 = d0 * -__expf(a->in[12][l * 16 + 2 * hp]), ac1 = d1 * -__expf(a->in[12][l * 16 + 2 * hp + 1]);
#pragma unroll
        for (int o = 1; o < 64; o <<= 1) { const int src = lane >= o ? lane - o : lane; const float t0 = bperm_f(ac0, src), t1 = bperm_f(ac1, src); if (lane >= o) { ac0 += t0; ac1 += t1; } }
        const float e0 = bperm_f(ac0, 63), e1 = bperm_f(ac1, 63);
        if (lane == 0) { wtot[wave] = e0; wtot[8 + wave] = e1; }
        WG_BAR();
        float p0 = 0.f, p1 = 0.f, T0 = 0.f, T1 = 0.f;
#pragma unroll
        for (int w = 0; w < 8; ++w) { const float x0 = wtot[w], x1 = wtot[8 + w]; T0 += x0; T1 += x1; if (w < wave) { p0 += x0; p1 += x1; } }
        ac0 += p0; ac1 += p1;
        wseg[row] = d0 * __expf(T0 - ac0); wseg[512 + row] = d1 * __expf(T1 - ac1);
        if (tid == 0) { SEGD[(b * 16 + 2 * hp) * (NSEG - 1) + seg] = T0; SEGD[(b * 16 + 2 * hp + 1) * (NSEG - 1) + seg] = T1; }
        WG_BAR();
    }
    f32x4 hacc[8];
#pragma unroll
    for (int j = 0; j < 8; ++j) hacc[j] = (f32x4){0.f, 0.f, 0.f, 0.f};
#define P1_TILE(tp, t) do { lbf* Xs = XsB + ((t) & 1) * (2 * S2_XH); lbf* Bm = BmB + ((t) & 1) * (64 * S2_LDN); \
        _Pragma("unroll") for (int i = 0; i < 4; ++i) { const int q_ = tid + 512 * i, row_ = q_ >> 5, pc_ = q_ & 31; \
            if (pc_ < 16) { const int hc = pc_ >> 3, p0 = (pc_ & 7) * 8; const float wl = wseg[hc * 512 + 64 * (t) + row_]; \
                float xv[8]; unpk8(tp[i], xv); v4u sx; sx.x = cvtpk(xv[0] * wl, xv[1] * wl); sx.y = cvtpk(xv[2] * wl, xv[3] * wl); sx.z = cvtpk(xv[4] * wl, xv[5] * wl); sx.w = cvtpk(xv[6] * wl, xv[7] * wl); \
                *(LAS v4u*)(Xs + hc * S2_XH + row_ * S2_LDX + p0) = sx; } \
            else *(LAS v4u*)(Bm + row_ * S2_LDN + (pc_ - 16) * 8) = tp[i]; } \
        if ((t) + 2 < 8) P1_PREFETCH(tp, (t) + 2); \
        WG_BAR(); \
        const bf16x8 xa0 = ldfrag_tr(Xs + hh * S2_XH, S2_LDX, 0, 16 * w4, lane), xa1 = ldfrag_tr(Xs + hh * S2_XH, S2_LDX, 32, 16 * w4, lane); \
        _Pragma("unroll") for (int jh = 0; jh < 2; ++jh) { bf16x8 bb[4][2]; \
            _Pragma("unroll") for (int j4 = 0; j4 < 4; ++j4) { bb[j4][0] = ldfrag_tr(Bm, S2_LDN, 0, 16 * (4 * jh + j4), lane); bb[j4][1] = ldfrag_tr(Bm, S2_LDN, 32, 16 * (4 * jh + j4), lane); } \
            asm volatile("" ::: "memory"); \
            _Pragma("unroll") for (int j4 = 0; j4 < 4; ++j4) { const int j = 4 * jh + j4; hacc[j] = MFMA16(bb[j4][0], xa0, hacc[j]); hacc[j] = MFMA16(bb[j4][1], xa1, hacc[j]); } } } while (0)
    for (int t2 = 0; t2 < 8; t2 += 2) { P1_TILE(tpA, t2); P1_TILE(tpB, t2 + 1); }
#undef P1_TILE
#undef P1_PREFETCH
    { const int uh = (b * 16 + h) * (NSEG - 1);
#pragma unroll
      for (int j = 0; j < 8; ++j) SEGE[(size_t)(uh + seg) * 2048 + (w4 * 8 + j) * 64 + lane] = (unsigned long long)cvtpk(hacc[j][0], hacc[j][1]) | ((unsigned long long)cvtpk(hacc[j][2], hacc[j][3]) << 32); }
    WG_BAR();
}

__device__ __forceinline__ void p2_conv(Frame& F, KArgs a, int l) {
    const bf16* XBC = (const bf16*)(F.ws + WS_XBC); bf16* CX = (bf16*)((unsigned char*)F.out + OUT_CX_BYTES);
    const int t = (255 - F.vcu) * 512 + F.tid;
    if (t >= 512 * 192 + 16 * 192) return;
    const bool smp = t >= 512 * 192; const int ts = smp ? t - 512 * 192 : t;
    const int rb = ts / 192, ccol = (ts % 192) * 8;
    const int row0 = smp ? MP + rb * 16 : rb * 32, nrow = smp ? 16 : 32;
    float cw[4][8], cb[8];
#pragma unroll
    for (int w = 0; w < 4; ++w) { const f32x4 t0 = *(const f32x4*)(a->in[9] + (size_t)(l * 4 + w) * 1536 + ccol), t1 = *(const f32x4*)(a->in[9] + (size_t)(l * 4 + w) * 1536 + ccol + 4);
        cw[w][0] = t0[0]; cw[w][1] = t0[1]; cw[w][2] = t0[2]; cw[w][3] = t0[3]; cw[w][4] = t1[0]; cw[w][5] = t1[1]; cw[w][6] = t1[2]; cw[w][7] = t1[3]; }
    { const f32x4 t0 = *(const f32x4*)(a->in[10] + (size_t)l * 1536 + ccol), t1 = *(const f32x4*)(a->in[10] + (size_t)l * 1536 + ccol + 4);
        cb[0] = t0[0]; cb[1] = t0[1]; cb[2] = t0[2]; cb[3] = t0[3]; cb[4] = t1[0]; cb[5] = t1[1]; cb[6] = t1[2]; cb[7] = t1[3]; }
    v4u raw[8];
#pragma unroll
    for (int k = 0; k < 8; ++k) raw[k] = __builtin_nontemporal_load((const v4u*)(XBC + (size_t)(row0 + k) * 1536 + ccol));
    float win[3][8];
    if (smp) {
#pragma unroll
        for (int k = 0; k < 3; ++k) { const float* hp_ = a->in[4] + ((size_t)(l * 16 + rb) * 3 + k) * 1536 + ccol; const f32x4 h0 = *(const f32x4*)hp_, h1 = *(const f32x4*)(hp_ + 4);
            win[k][0] = h0[0]; win[k][1] = h0[1]; win[k][2] = h0[2]; win[k][3] = h0[3]; win[k][4] = h1[0]; win[k][5] = h1[1]; win[k][6] = h1[2]; win[k][7] = h1[3]; }
    } else if ((row0 & 4095) != 0) {
#pragma unroll
        for (int k = 0; k < 3; ++k) unpk8(*(const v4u*)(XBC + (size_t)(row0 - 3 + k) * 1536 + ccol), win[k]);
    } else {
#pragma unroll
        for (int k = 0; k < 3; ++k)
#pragma unroll
            for (int e = 0; e < 8; ++e) win[k][e] = 0.f;
    }
    const int nq = nrow / 8;
    for (int qb = 0; qb < nq; ++qb) {
        v4u nxt[8];
        const int rn = row0 + ((qb + 1 < nq) ? (qb + 1) * 8 : qb * 8);
#pragma unroll
        for (int k = 0; k < 8; ++k) nxt[k] = __builtin_nontemporal_load((const v4u*)(XBC + (size_t)(rn + k) * 1536 + ccol));
#pragma unroll
        for (int jr = 0; jr < 8; ++jr) { float cur[8], o[8]; unpk8(raw[jr], cur);
#pragma unroll
            for (int e = 0; e < 8; ++e) { float v = cb[e] + cw[0][e] * win[0][e] + cw[1][e] * win[1][e] + cw[2][e] * win[2][e] + cw[3][e] * cur[e];
                o[e] = v * sigm(v); win[0][e] = win[1][e]; win[1][e] = win[2][e]; win[2][e] = cur[e]; }
            v4u pk; pk.x = cvtpk(o[0], o[1]); pk.y = cvtpk(o[2], o[3]); pk.z = cvtpk(o[4], o[5]); pk.w = cvtpk(o[6], o[7]);
            *(v4u*)(CX + (size_t)(row0 + qb * 8 + jr) * 1536 + ccol) = pk; }
#pragma unroll
        for (int k = 0; k < 8; ++k) raw[k] = nxt[k];
    }
}
__device__ __forceinline__ void p2_mixers_a(Frame& F, KArgs a, int l) {
    const int v = F.vcu, seg = v & 7;
    if (seg < NSEG - 1) ssd_pass1(F, a, l, v >> 6, (v >> 3) & 7, seg);
}
__device__ __forceinline__ void p2_attention(Frame& F, KArgs a, int l) {
    const int v = F.vcu;
    attn_tables(F, a);
    for (int i = 0; i < 3; ++i) { const int u = i < 2 ? 2 * v + i : 512 + v;
        if (u >= 544) break;
        if (u < 512) attn_unit<false>(F, a, l, u >> 7, (u >> 1) & 63, u & 1);
        else attn_unit<true>(F, a, l, (u - 512) >> 1, 0, u & 1); }
    const bf16* XBC = (const bf16*)(F.ws + WS_XBC);
    for (int e = v * 512 + F.tid; e < 20 * 3 * 1536; e += 256 * 512) {
        const int ch = e % 1536, j = (e / 1536) % 3, s = e / 4608;
        if (s < 4) F.out[O_CP + ((size_t)(l * 4 + s) * 3 + j) * 1536 + ch] = bf2f(XBC[(size_t)(s * 4096 + 4093 + j) * 1536 + ch]);
        else F.out[O_CS + ((size_t)(l * 16 + s - 4) * 3 + j) * 1536 + ch] = bf2f(XBC[(size_t)(MP + (s - 4) * 16 + 13 + j) * 1536 + ch]);
    }
}
__device__ __forceinline__ void p2_mixers_b(Frame& F, KArgs a, int l) {
    const int v = F.vcu;
    ssd_unit<0>(F, a, l, v >> 6, (v >> 3) & 7, v & 7);
    FRAME_REOPAQUE(F);
    if ((v & 7) < 4) { const int u = (v >> 3) * 4 + (v & 3); ssd_unit<2>(F, a, l, u >> 3, u & 7, 0); }
}

template <int NSTEP, int NB = 4>
__device__ __forceinline__ void mini_acc(f32x4 (&acc)[4], const bf16* A, int lda, const bf16* W, int ldw, int row0, int pn, int wc, int kbase, int lane) {
    const int fr = lane & 15, q4 = lane >> 4;
    const bf16* ap = A + (size_t)(row0 + fr) * lda + kbase + 8 * q4;
    const bf16* wp = W + (size_t)(256 * pn + 32 * wc + fr) * ldw + kbase + 8 * q4;
#pragma unroll
    for (int s0 = 0; s0 < NSTEP; s0 += NB) {
        bf16x8 af[NB], wf[NB][4];
#pragma unroll
        for (int q = 0; q < NB; ++q) { if (s0 + q < NSTEP) { af[q] = *(const bf16x8*)(ap + 32 * (s0 + q));
#pragma unroll
            for (int ct = 0; ct < 4; ++ct) wf[q][ct] = *(const bf16x8*)(wp + (size_t)(128 * (ct >> 1) + 16 * (ct & 1)) * ldw + 32 * (s0 + q)); } }
        asm volatile("" ::: "memory");
#pragma unroll
        for (int q = 0; q < NB; ++q) { if (s0 + q < NSTEP) {
#pragma unroll
            for (int ct = 0; ct < 4; ++ct) acc[ct] = MFMA16(af[q], wf[q][ct], acc[ct]); } }
    }
}
__device__ __forceinline__ void mini_acc_merge(f32x4 (&a1)[4], f32x4 (&a2)[4], const bf16* A, const bf16* W, int row0, int pn, int wc, int wave, int lane) {
    const int fr = lane & 15, q4 = lane >> 4;
    const bf16* ap1 = A + (size_t)(row0 + fr) * OY_LD + wave * 64 + 8 * q4; const bf16* ap2 = A + (size_t)(row0 + fr) * OY_LD + OY_Z + wave * 128 + 8 * q4;
    const bf16* wp1 = W + (size_t)(256 * pn + 32 * wc + fr) * 1536 + wave * 64 + 8 * q4; const bf16* wp2 = W + (size_t)(256 * pn + 32 * wc + fr) * 1536 + 512 + wave * 128 + 8 * q4;
    bf16x8 af1[2], wf1[2][4], af2[4], wf2[4][4];
#pragma unroll
    for (int q = 0; q < 2; ++q) { af1[q] = *(const bf16x8*)(ap1 + 32 * q);
#pragma unroll
        for (int ct = 0; ct < 4; ++ct) wf1[q][ct] = *(const bf16x8*)(wp1 + (size_t)(128 * (ct >> 1) + 16 * (ct & 1)) * 1536 + 32 * q); }
#pragma unroll
    for (int q = 0; q < 4; ++q) { af2[q] = *(const bf16x8*)(ap2 + 32 * q);
#pragma unroll
        for (int ct = 0; ct < 4; ++ct) wf2[q][ct] = *(const bf16x8*)(wp2 + (size_t)(128 * (ct >> 1) + 16 * (ct & 1)) * 1536 + 32 * q); }
    asm volatile("" ::: "memory");
#pragma unroll
    for (int q = 0; q < 2; ++q)
#pragma unroll
        for (int ct = 0; ct < 4; ++ct) a1[ct] = MFMA16(af1[q], wf1[q][ct], a1[ct]);
#pragma unroll
    for (int q = 0; q < 4; ++q)
#pragma unroll
        for (int ct = 0; ct < 4; ++ct) a2[ct] = MFMA16(af2[q], wf2[q][ct], a2[ct]);
}
__device__ __forceinline__ void mini_reduce(Frame& F, const f32x4 (&acc)[4], LAS float* red, f32x4& v) {
#pragma unroll
    for (int ct = 0; ct < 4; ++ct)
#pragma unroll
        for (int i = 0; i < 4; ++i) red[((F.wave * 4 + ct) * 4 + i) * 64 + F.lane] = acc[ct][i];
    __syncthreads();
    v = (f32x4){0.f, 0.f, 0.f, 0.f};
    if (F.wave < 4) {
#pragma unroll
        for (int w = 0; w < 8; ++w)
#pragma unroll
            for (int i = 0; i < 4; ++i) v[i] += red[((w * 4 + F.wave) * 4 + i) * 64 + F.lane];
    }
}
__device__ __forceinline__ void mini_merge(Frame& F) {
    const int v_ = F.vcu, rb = v_ >> 4, cs = v_ & 15, pn = cs >> 2, wc = cs & 3, row0 = MP + 16 * rb;
    f32x4 a1[4], a2[4];
#pragma unroll
    for (int ct = 0; ct < 4; ++ct) { a1[ct] = (f32x4){0.f, 0.f, 0.f, 0.f}; a2[ct] = (f32x4){0.f, 0.f, 0.f, 0.f}; }
    const int ect = F.wave & 3, ecol = 256 * pn + 128 * (ect >> 1) + 32 * wc + 16 * (ect & 1) + (F.lane & 15);
    unsigned short gav[4], gsv[4]; f32x4 sqv[4][4];
#pragma unroll
    for (int i = 0; i < 4; ++i) { const int row = row0 + 4 * (F.lane >> 4) + i; const size_t off = (size_t)row * 1024 + ecol;
        gav[i] = ((const bf16*)(F.ws + WS_GA))[off]; gsv[i] = ((const bf16*)(F.ws + WS_GS))[off];
        const f32x4* sp = (const f32x4*)((const float*)(F.ws + WS_SSQY) + (size_t)row * 16);
#pragma unroll
        for (int j = 0; j < 4; ++j) sqv[i][j] = sp[j]; }
    mini_acc_merge(a1, a2, (const bf16*)(F.ws + WS_Q), (const bf16*)(F.ws + WS_WATT), row0, pn, wc, F.wave, F.lane);
    f32x4 v1, v2;
    mini_reduce(F, a1, (LAS float*)F.lds, v1);
    mini_reduce(F, a2, (LAS float*)(F.lds + 32768), v2);
    if (F.wave < 4) { bf16* MG = (bf16*)(F.ws + WS_MG);
#pragma unroll
        for (int i = 0; i < 4; ++i) { const int row = row0 + 4 * (F.lane >> 4) + i; const size_t off = (size_t)row * 1024 + ecol;
            const f32x4 sq4 = (sqv[i][0] + sqv[i][1]) + (sqv[i][2] + sqv[i][3]);
            const float rs = rsqrtf(((sq4[0] + sq4[1]) + (sq4[2] + sq4[3])) * (1.0f / 1024.0f) + 1e-6f);
            MG[off] = (unsigned short)(cvtpk(bf2f(gav[i]) * v1[i] + bf2f(gsv[i]) * (v2[i] * rs), 0.f) & 0xffffu); } }
    __syncthreads();
}
template <int NSTEP>
__device__ __forceinline__ void mini_res(Frame& F, const bf16* A, int K, const bf16* W, int ssq_off) {
    const int v_ = F.vcu, rb = v_ >> 4, cs = v_ & 15, pn = cs >> 2, wc = cs & 3, row0 = MP + 16 * rb;
    f32x4 a1[4];
#pragma unroll
    for (int ct = 0; ct < 4; ++ct) a1[ct] = (f32x4){0.f, 0.f, 0.f, 0.f};
    const int ect = F.wave & 3, ecol = 256 * pn + 128 * (ect >> 1) + 32 * wc + 16 * (ect & 1) + (F.lane & 15);
    unsigned short xbv[4];
#pragma unroll
    for (int i = 0; i < 4; ++i) xbv[i] = ((const bf16*)(F.ws + WS_XB))[(size_t)(row0 + 4 * (F.lane >> 4) + i) * 1024 + ecol];
    mini_acc<NSTEP, (NSTEP > 4 ? 6 : 4)>(a1, A, K, W, K, row0, pn, wc, F.wave * (32 * NSTEP), F.lane);
    f32x4 v1;
    mini_reduce(F, a1, (LAS float*)F.lds, v1);
    LAS float* part = (LAS float*)(F.lds + 32768);
    if (F.wave < 4) { const int ct = F.wave;
        bf16* XB = (bf16*)(F.ws + WS_XB);
#pragma unroll
        for (int i = 0; i < 4; ++i) { const int rl = 4 * (F.lane >> 4) + i, row = row0 + rl; const size_t off = (size_t)row * 1024 + ecol;
            const float h = bf2f(xbv[i]) + v1[i];
            XB[off] = (unsigned short)(cvtpk(h, 0.f) & 0xffffu);
            float s = h * h; s += shx(s, 1, F.lane); s += shx(s, 2, F.lane); s += shx(s, 4, F.lane); s += shx(s, 8, F.lane);
            if ((F.lane & 15) == 0) part[ct * 16 + rl] = s; } }
    __syncthreads();
    if (F.tid < 16) ((float*)(F.ws + ssq_off))[(size_t)(row0 + F.tid) * 16 + cs] = (part[F.tid] + part[16 + F.tid]) + (part[32 + F.tid] + part[48 + F.tid]);
    __syncthreads();
}

#if PROBE_MASK && SUBPROBE
#define SPAN(id, ...) do { unsigned long long sp_ = 0ull; if (SUBPROBE == (id)) sp_ = rt(); __VA_ARGS__; if (SUBPROBE == (id)) pr_acc += rt() - sp_; } while (0)
#else
#define SPAN(id, ...) do { __VA_ARGS__; } while (0)
#endif
__global__ void __launch_bounds__(NWAVES * 64, 2) enc_fwd(Args args) {
    extern __shared__ __attribute__((aligned(16))) unsigned char lds[];
    Frame F;
    F.lds = (LAS unsigned char*)lds;
    F.MISC = (volatile LAS unsigned*)(F.lds + MISC_OFF);
    F.tid = threadIdx.x; F.lane = F.tid & 63; F.wave = __builtin_amdgcn_readfirstlane(F.tid >> 6);
    F.G = gridDim.x; { const int bx = blockIdx.x; F.vcu = (F.G % 8 == 0) ? (bx % 8) * (F.G / 8) + bx / 8 : bx; }
    F.ctl = (gu32*)(args.ws + WS_CTL);
    for (int u = F.tid; u < (LDS_BYTES - LDSCTL_OFF) / 4; u += NWAVES * 64) ((LAS unsigned*)(F.lds + LDSCTL_OFF))[u] = 0u;
    __syncthreads();
    XcdBarrier bar; bar.bar = (unsigned*)(F.ctl + CW_BAR); bar.x = 0; bar.st = nullptr;
    if (!MK_SPLIT) bar = xcd_barrier_post((unsigned*)(F.ctl + CW_BAR), F.MISC + 8);
    const int lo = args.ph_lo, hi = args.ph_hi;
#if PROBE_MASK
    unsigned long long pr_acc = 0ull, pr_prev = rt();
#endif
    for (int ph = lo; ph < hi; ++ph) {
        if (ph == 9 && !MK_SPLIT) continue;
        if (ph > lo && !MK_SPLIT) { if ((ph - 1) % 9 == SUBPROBE / 10 && SUBPROBE % 10 == 3) SPAN(SUBPROBE, xcd_barrier(bar)); else xcd_barrier(bar); }
#if PROBE_MASK
        { const unsigned long long now_ = rt(); if (!SUBPROBE && ph > lo && ((PROBE_MASK >> ((ph - 1) == NPHASE - 1 ? 9 : (ph - 1) % 9)) & 1)) pr_acc += now_ - pr_prev; pr_prev = now_; }
#endif
        { int tv = threadIdx.x; asm volatile("" : "+v"(tv)); F.tid = tv; F.lane = tv & 63; F.wave = __builtin_amdgcn_readfirstlane(tv >> 6); }
        KArgs ka = (KArgs)__builtin_amdgcn_kernarg_segment_ptr(); asm volatile("" : "+s"(ka));
        unsigned char* ws = ka->ws; float* outp = ka->out; F.ws = ws; F.out = outp;
        const int l = ph / 9, k = ph % 9;
        if (PH_EN(9) && ph == NPHASE - 1) {
            const int gw = F.vcu * NWAVES + F.wave, NGW = F.G * NWAVES;
            for (int m = gw; m < MALL; m += NGW) {
                const float rs = epi::row_rs((const float*)(ws + WS_SSQX), m);
                GAS f32x4* yr = (GAS f32x4*)(outp + (size_t)m * DM) + F.lane; const GAS f32x4* gr = (const GAS f32x4*)ka->in[23] + F.lane;
                const GAS unsigned long long* xb = (const GAS unsigned long long*)((const bf16*)(ws + WS_XB) + (size_t)m * DM) + F.lane;
#pragma unroll
                for (int j = 0; j < 4; ++j) { const unsigned long long w = __builtin_nontemporal_load(xb + 64 * j); const f32x4 gg = gr[64 * j];
                    f32x4 v = (f32x4){__uint_as_float((unsigned)w << 16), __uint_as_float((unsigned)w & 0xffff0000u), __uint_as_float((unsigned)(w >> 32) << 16), __uint_as_float((unsigned)(w >> 32) & 0xffff0000u)};
                    v = v * rs * gg; __builtin_nontemporal_store(v, (f32x4*)(outp + (size_t)m * DM) + F.lane + 64 * j); }
            }
        } else if (PH_EN(0) && k == 0) { p0_convert(F, ka, l);
        } else if (PH_EN(1) && k == 1) {
            if (l == 1 && !MK_SPLIT) { p0_convert_slack<1>(F, ka, 1); __syncthreads(); FRAME_REOPAQUE(F); }
            if (l == 0 && !MK_SPLIT) { p0_convert_slack<2>(F, ka, 0); __syncthreads(); FRAME_REOPAQUE(F); }
            pg8::Gemm g{(const bf16*)(ws + WS_XB), (const bf16*)(ws + WS_WIN), MALL, NU, 1024}; pg8::StaticOrder S; S.init(MALL, NU, F.G, (int)blockIdx.x);
            epi::EpiIn E{ws, ka->in[11] + l * 16};
            pg8::gemm_phase<epi::EpiIn, pg8::StaticOrder, true, true>(F.lds, g, S, E);
        } else if (PH_EN(2) && k == 2) { p2_conv(F, ka, l); FRAME_REOPAQUE(F); p2_attention(F, ka, l);
        } else if (PH_EN(3) && k == 3) { p2_mixers_a(F, ka, l);
        } else if (PH_EN(4) && k == 4) { p2_mixers_b(F, ka, l);
        } else if (PH_EN(5) && k == 5) {
            { pg8::Gemm g{(const bf16*)(ws + WS_Q), (const bf16*)(ws + WS_WATT), MP, 1024, 1536}; pg8::StaticOrder S; S.init(MP, 1024, F.G, (int)blockIdx.x);
              { pg8::Unit u0; if (S.next(0, u0) && F.tid < 256) EPI_RSL[F.tid] = epi::row_rs((const float*)(ws + WS_SSQY), u0.pm * 256 + F.tid); }
              __syncthreads();
              epi::EpiMerge E{ws}; SPAN(51, pg8::gemm_phase<epi::EpiMerge, pg8::StaticOrder, true, true>(F.lds, g, S, E)); }
            FRAME_REOPAQUE(F); SPAN(52, mini_merge(F));
        } else if (PH_EN(6) && k == 6) {
            pg8::Gemm g{(const bf16*)(ws + WS_MG), (const bf16*)(ws + WS_WOUT), MP, 1024, 1024}; pg8::StaticOrder S; S.init(MP, 1024, F.G, (int)blockIdx.x);
            epi::EpiRes E{ws, (int)WS_SSQH};
            SPAN(61, pg8::gemm_phase<epi::EpiRes, pg8::StaticOrder, false, true>(F.lds, g, S, E));
            FRAME_REOPAQUE(F); SPAN(62, mini_res<4>(F, (const bf16*)(ws + WS_MG), 1024, (const bf16*)(ws + WS_WOUT), (int)WS_SSQH));
        } else if (PH_EN(7) && k == 7) {
            pg8::Gemm g{(const bf16*)(ws + WS_XB), (const bf16*)(ws + WS_WGU), MALL, NU, 1024}; pg8::StaticOrder S; S.init(MALL, NU, F.G, (int)blockIdx.x);
            epi::EpiGlu E{ws};
            if (l == 0 && !MK_SPLIT) { p0_convert_slack<0>(F, ka, 1); __syncthreads(); FRAME_REOPAQUE(F); }
            pg8::gemm_phase<epi::EpiGlu, pg8::StaticOrder, true, true>(F.lds, g, S, E);
        } else if (PH_EN(8) && k == 8) {
            pg8::Gemm g{(const bf16*)(ws + WS_ACT), (const bf16*)(ws + WS_WDN), MP, 1024, DFF}; pg8::StaticOrder S; S.init(MP, 1024, F.G, (int)blockIdx.x);
            epi::EpiRes E{ws, (int)WS_SSQX};
            SPAN(81, pg8::gemm_phase<epi::EpiRes, pg8::StaticOrder, false, true>(F.lds, g, S, E));
            FRAME_REOPAQUE(F); SPAN(82, mini_res<11>(F, (const bf16*)(ws + WS_ACT), DFF, (const bf16*)(ws + WS_WDN), (int)WS_SSQX));
        }
    }
#if PROBE_MASK
    { const unsigned long long now_ = rt(); if (!SUBPROBE && ((PROBE_MASK >> ((hi - 1) == NPHASE - 1 ? 9 : (hi - 1) % 9)) & 1)) pr_acc += now_ - pr_prev;
      if (blockIdx.x == 0) { const unsigned long long t0_ = rt(); while (rt() - t0_ < (unsigned long long)PROBE_K * pr_acc) __builtin_amdgcn_s_sleep(8); } }
#endif
}

extern "C" void kernel_launch(void* const* d_in, const int* in_sizes, int n_in, void* d_out, int out_size, void* d_ws, size_t ws_size, hipStream_t stream) {
    static int ready = 0;
    if (ready == 0) {
        if (n_in != 24 || out_size != (int)O_END || ws_size < WS_END) { fprintf(stderr, "kernel_launch: unexpected problem shape (n_in %d, out %d, ws %zu); nothing launched\n", n_in, out_size, ws_size); ready = -1; return; }
        if (hipFuncSetAttribute((const void*)enc_fwd, hipFuncAttributeMaxDynamicSharedMemorySize, LDS_BYTES) != hipSuccess) { fprintf(stderr, "kernel_launch: hipFuncSetAttribute failed\n"); ready = -1; return; }
        { int dev = 0, cus = 0, per_cu = 0;
          if (hipGetDevice(&dev) == hipSuccess && hipDeviceGetAttribute(&cus, hipDeviceAttributeMultiprocessorCount, dev) == hipSuccess && cus < 256)
              fprintf(stderr, "kernel_launch: this kernel needs 256 co-resident workgroups (one per CU); the device reports %d CUs: the grid barrier would give up and the output would be wrong\n", cus);
          if (hipOccupancyMaxActiveBlocksPerMultiprocessor(&per_cu, (const void*)enc_fwd, NWAVES * 64, LDS_BYTES) != hipSuccess || per_cu < 1)
              fprintf(stderr, "kernel_launch: note: the occupancy query reports %d workgroups per CU for %d B of LDS\n", per_cu, LDS_BYTES); }
        (void)hipGetLastError();
        ready = 1;
    }
    if (ready < 0) return;
    if (hipMemsetAsync((char*)d_ws + WS_CTL, 0, CTL_ZERO_BYTES, stream) != hipSuccess) { fprintf(stderr, "kernel_launch: hipMemsetAsync failed\n"); return; }
    Args a{};
    for (int i = 0; i < 24; ++i) a.in[i] = (const float*)d_in[i];
    a.out = (float*)d_out; a.ws = (unsigned char*)d_ws;
#if MK_SPLIT
    for (int ph = 0; ph < NPHASE; ++ph) { a.ph_lo = ph; a.ph_hi = ph + 1; a.li = ph; hipLaunchKernelGGL(enc_fwd, dim3(256), dim3(NWAVES * 64), LDS_BYTES, stream, a); }
#else
    a.ph_lo = 0; a.ph_hi = NPHASE; a.li = 0;
    hipLaunchKernelGGL(enc_fwd, dim3(256), dim3(NWAVES * 64), LDS_BYTES, stream, a);
#endif
    const hipError_t le = hipPeekAtLastError();
    if (le != hipSuccess) fprintf(stderr, "kernel_launch: launch failed: %s\n", hipGetErrorName(le));
}
```
